# Optimizing an MI355X kernel written in HIP

```python
import math
import jax, jax.numpy as jnp
from jax import lax
import numpy as np

D_MODEL = 2048
BATCH = 4
SEQ = 2048
DEPTH = 4
DEC_BATCH = 8
DEC_SEQ = 64
PAST_LEN = 1024

CHUNK = 64
Q_BLOCK = 128
D_CONV = 1024
CONV_W = 3
N_HEADS = 8
HEAD_DIM = D_MODEL // N_HEADS // 2
D_ATTN = 2 * N_HEADS * HEAD_DIM
D_FF = ((8 * D_MODEL // 3 + 255) // 256) * 256
NUM_BUCKETS = 32
MAX_DISTANCE = 128
D_PLE = 256
EPS = 1e-6
D_IN = 3 * D_CONV + 3 * D_ATTN + 2 * D_MODEL
SPLITS = [D_CONV, 2 * D_CONV, 3 * D_CONV, 3 * D_CONV + D_ATTN, 3 * D_CONV + 2 * D_ATTN,
          3 * D_CONV + 3 * D_ATTN, 3 * D_CONV + 3 * D_ATTN + D_MODEL]

kernel_name = "hybrid_conv_diffattn_stream_step"


def rmsnorm(x, g):
    xf = x.astype(jnp.float32)
    y = xf * lax.rsqrt(jnp.mean(xf * xf, axis=-1, keepdims=True) + EPS)
    return (y * g.astype(jnp.float32)).astype(x.dtype)


def rel_bucket(rel):
    half = NUM_BUCKETS // 2
    max_exact = half // 2
    offset = jnp.where(rel > 0, half, 0)
    n = jnp.abs(rel)
    nf = jnp.maximum(n, 1).astype(jnp.float32)
    large = max_exact + (jnp.log(nf / max_exact) / math.log(MAX_DISTANCE / max_exact)
                         * (half - max_exact)).astype(jnp.int32)
    large = jnp.minimum(large, half - 1)
    return offset + jnp.where(n < max_exact, n, large)


def diff_attend(q, k, v, q_pos, k_pos, rel_table, lam):
    s = jnp.einsum('bqhmd,bkhmd->bmhqk', q, k).astype(jnp.float32) * (HEAD_DIM ** -0.5)
    bias = jnp.transpose(rel_table[rel_bucket(k_pos[None, :] - q_pos[:, None])], (2, 0, 1))
    mask = (k_pos[None, :] // CHUNK) <= (q_pos[:, None] // CHUNK)
    s = jnp.where(mask, s + bias.astype(jnp.float32), -1e30)
    a = jax.nn.softmax(s, axis=-1)
    w = a[:, 0] - lam * a[:, 1]
    return jnp.einsum('bhqk,bkhe->bqhe', w.astype(v.dtype), v)


def attn_prompt(q, k, v, rel_table, lam):
    b, s = q.shape[0], q.shape[1]
    nb = s // Q_BLOCK
    qb = jnp.swapaxes(q.reshape(b, nb, Q_BLOCK, N_HEADS, 2, HEAD_DIM), 0, 1)
    k_pos = jnp.arange(s)

    def block(args):
        qi, bi = args
        q_pos = bi * Q_BLOCK + jnp.arange(Q_BLOCK)
        return diff_attend(qi, k, v, q_pos, k_pos, rel_table, lam)

    o = lax.map(block, (qb, jnp.arange(nb)))
    return jnp.swapaxes(o, 0, 1).reshape(b, s, N_HEADS, 2 * HEAD_DIM)


def trunk_layer(x, p_i, conv_prev, k_past, v_past, i, rel_table, g_mix, w_in, conv_w,
                lq1, lk1, lq2, lk2, g_sub, w_br_a, w_br_b, w_out, g_ffn, w1, w3, w2,
                g_ple, w_ple_proj, w_ple_gate):
    b, L = x.shape[0], x.shape[1]
    h = rmsnorm(x, g_mix)
    z = h @ w_in
    b_g, c_g, xin, q, k, v, ga, gb = jnp.split(z, SPLITS, axis=-1)
    u = c_g * xin
    ext = jnp.concatenate([conv_prev.astype(u.dtype), u], axis=1)
    conv = ext[:, 0:L] * conv_w[0] + ext[:, 1:L + 1] * conv_w[1] + ext[:, 2:L + 2] * conv_w[2]
    y_a = (b_g * conv) @ w_br_a
    new_conv = ext[:, L:]
    q = q.reshape(b, L, N_HEADS, 2, HEAD_DIM)
    k = k.reshape(b, L, N_HEADS, 2 * HEAD_DIM)
    v = v.reshape(b, L, N_HEADS, 2 * HEAD_DIM)
    lam_init = 0.8 - 0.6 * math.exp(-0.3 * i)
    lam = (jnp.exp(jnp.sum(lq1.astype(jnp.float32) * lk1.astype(jnp.float32)))
           - jnp.exp(jnp.sum(lq2.astype(jnp.float32) * lk2.astype(jnp.float32))) + lam_init)
    if k_past is None:
        o = attn_prompt(q, k.reshape(b, L, N_HEADS, 2, HEAD_DIM), v, rel_table, lam)
    else:
        past = k_past.shape[1]
        k_all = jnp.concatenate([k_past.astype(k.dtype), k], axis=1)
        v_all = jnp.concatenate([v_past.astype(v.dtype), v], axis=1)
        q_pos = past + jnp.arange(L)
        k_pos = jnp.arange(past + L)
        o = diff_attend(q, k_all.reshape(b, past + L, N_HEADS, 2, HEAD_DIM), v_all,
                        q_pos, k_pos, rel_table, lam)
    o = rmsnorm(o, g_sub) * (1.0 - lam_init)
    y_b = o.reshape(b, L, D_ATTN) @ w_br_b
    m = jax.nn.sigmoid(ga) * y_a + jax.nn.sigmoid(gb) * y_b
    x = x + m @ w_out
    h = rmsnorm(x, g_ffn)
    x = x + (jax.nn.silu(h @ w1) * (h @ w3)) @ w2
    x = x + (p_i @ w_ple_proj) * jax.nn.sigmoid(rmsnorm(x, g_ple) @ w_ple_gate)
    return x, new_conv, k, v


def setup_inputs(seed: int = 0) -> dict:
    key = jax.random.key(seed)
    ks = jax.random.split(key, 32)
    nrm = lambda k, shape, scale: jax.random.normal(k, shape, jnp.float32) * scale
    gain = lambda k, shape: 1.0 + 0.02 * jax.random.normal(k, shape, jnp.float32)
    return {
        "x_prompt": nrm(ks[0], (BATCH, SEQ, D_MODEL), 1.0),
        "x_sample": nrm(ks[1], (DEC_BATCH, DEC_SEQ, D_MODEL), 1.0),
        "p_prompt": nrm(ks[2], (DEPTH, BATCH, SEQ, D_PLE), 1.0),
        "p_sample": nrm(ks[3], (DEPTH, DEC_BATCH, DEC_SEQ, D_PLE), 1.0),
        "cache_k": nrm(ks[4], (DEPTH, DEC_BATCH, PAST_LEN, N_HEADS, 2 * HEAD_DIM), 1.0),
        "cache_v": nrm(ks[5], (DEPTH, DEC_BATCH, PAST_LEN, N_HEADS, 2 * HEAD_DIM), 1.0),
        "cache_conv": nrm(ks[6], (DEPTH, DEC_BATCH, CONV_W - 1, D_CONV), 1.0),
        "rel_table": nrm(ks[7], (NUM_BUCKETS, N_HEADS), 0.5),
        "g_mix": gain(ks[8], (DEPTH, D_MODEL)),
        "w_in": nrm(ks[9], (DEPTH, D_MODEL, D_IN), D_MODEL ** -0.5),
        "conv_w": nrm(ks[10], (DEPTH, CONV_W, D_CONV), CONV_W ** -0.5),
        "lam_q1": nrm(ks[11], (DEPTH, HEAD_DIM), 0.1),
        "lam_k1": nrm(ks[12], (DEPTH, HEAD_DIM), 0.1),
        "lam_q2": nrm(ks[13], (DEPTH, HEAD_DIM), 0.1),
        "lam_k2": nrm(ks[14], (DEPTH, HEAD_DIM), 0.1),
        "g_sub": gain(ks[15], (DEPTH, 2 * HEAD_DIM)),
        "w_br_a": nrm(ks[16], (DEPTH, D_CONV, D_MODEL), D_CONV ** -0.5),
        "w_br_b": nrm(ks[17], (DEPTH, D_ATTN, D_MODEL), D_ATTN ** -0.5),
        "w_out": nrm(ks[18], (DEPTH, D_MODEL, D_MODEL), D_MODEL ** -0.5),
        "g_ffn": gain(ks[19], (DEPTH, D_MODEL)),
        "w1": nrm(ks[20], (DEPTH, D_MODEL, D_FF), D_MODEL ** -0.5),
        "w3": nrm(ks[21], (DEPTH, D_MODEL, D_FF), D_MODEL ** -0.5),
        "w2": nrm(ks[22], (DEPTH, D_FF, D_MODEL), D_FF ** -0.5),
        "g_ple": gain(ks[23], (DEPTH, D_MODEL)),
        "w_ple_proj": nrm(ks[24], (DEPTH, D_PLE, D_MODEL), D_PLE ** -0.5),
        "w_ple_gate": nrm(ks[25], (DEPTH, D_MODEL, D_MODEL), D_MODEL ** -0.5),
        "g_final": gain(ks[26], (D_MODEL,)),
    }


def reference(x_prompt, x_sample, p_prompt, p_sample, cache_k, cache_v, cache_conv, rel_table,
              g_mix, w_in, conv_w, lam_q1, lam_k1, lam_q2, lam_k2, g_sub, w_br_a, w_br_b,
              w_out, g_ffn, w1, w3, w2, g_ple, w_ple_proj, w_ple_gate, g_final):
    xp, xs = x_prompt, x_sample
    kp_l, vp_l, cp_l, ks_l, vs_l, cs_l = [], [], [], [], [], []
    conv_zero = jnp.zeros((x_prompt.shape[0], CONV_W - 1, D_CONV), x_prompt.dtype)
    for i in range(DEPTH):
        lw = (rel_table, g_mix[i], w_in[i], conv_w[i], lam_q1[i], lam_k1[i], lam_q2[i], lam_k2[i],
              g_sub[i], w_br_a[i], w_br_b[i], w_out[i], g_ffn[i], w1[i], w3[i], w2[i],
              g_ple[i], w_ple_proj[i], w_ple_gate[i])
        xp, cp, kp, vp = trunk_layer(xp, p_prompt[i], conv_zero, None, None, i, *lw)
        xs, cs, ks_, vs = trunk_layer(xs, p_sample[i], cache_conv[i], cache_k[i], cache_v[i], i, *lw)
        kp_l.append(kp); vp_l.append(vp); cp_l.append(cp)
        ks_l.append(ks_); vs_l.append(vs); cs_l.append(cs)
    y_prompt = rmsnorm(xp, g_final)
    y_sample = rmsnorm(xs, g_final)
    k_prompt = jnp.stack(kp_l); v_prompt = jnp.stack(vp_l); conv_prompt = jnp.stack(cp_l)
    k_sample = jnp.stack(ks_l); v_sample = jnp.stack(vs_l); conv_sample = jnp.stack(cs_l)
    return (y_prompt, y_sample, k_prompt, v_prompt, conv_prompt, k_sample, v_sample, conv_sample)
```

```cpp
#include <hip/hip_runtime.h>
#include <hip/hip_bf16.h>
#include <cstdio>
#include <cstdint>

constexpr int DM = 2048, NB = 4, SEQ = 2048, DEPTH = 4, DB = 8, DSEQ = 64, PAST = 1024;
constexpr int DCONV = 1024, NH = 8, HD = 128, DATTN = 2048, DFF = 5632, DPLE = 256, DIN = 13312;
constexpr int MP = NB * SEQ, MS = DB * DSEQ, M = MP + MS;
constexpr int KROWS = 1152;
constexpr float EPS = 1e-6f;
constexpr int KBR = DCONV + DATTN;
constexpr int KPLE = DPLE + DM;
constexpr int NUP = 2 * DFF;

constexpr size_t MiB = 1u << 20;
constexpr size_t alignMiB(size_t x) { return (x + MiB - 1) / MiB * MiB; }
constexpr size_t WS_CTL = 0, CTL_ZERO_BYTES = 32768;
constexpr size_t LW_IN = 0, LW_BR = LW_IN + (size_t)DIN * DM * 2, LW_OUT = LW_BR + (size_t)DM * KBR * 2, LW_13 = LW_OUT + (size_t)DM * DM * 2,
                 LW_2 = LW_13 + (size_t)NUP * DM * 2, LW_PLE = LW_2 + (size_t)DM * DFF * 2, LW_BYTES = LW_PLE + (size_t)DM * KPLE * 2;
constexpr size_t WS_W = 1 * MiB;
constexpr size_t WS_KALL = WS_W + DEPTH * LW_BYTES;
constexpr size_t KALL_BYTES = (size_t)DEPTH * DB * KROWS * DM * 2;
constexpr size_t WS_VALL = WS_KALL + KALL_BYTES;
constexpr size_t WS_X = WS_VALL + KALL_BYTES;
constexpr size_t WS_AH = alignMiB(WS_X + (size_t)M * DM * 4);
constexpr size_t WS_APLE = alignMiB(WS_AH + (size_t)M * DM * 2);
constexpr size_t APLE_BYTES = alignMiB((size_t)M * KPLE * 2);
constexpr size_t WS_ZC = WS_APLE + DEPTH * APLE_BYTES;
constexpr size_t WS_QB = alignMiB(WS_ZC + (size_t)M * 3072 * 2);
constexpr size_t WS_KB = alignMiB(WS_QB + (size_t)(M + 256) * DM * 2);
constexpr size_t WS_VB = alignMiB(WS_KB + (size_t)MP * DM * 2);
constexpr size_t WS_GG = alignMiB(WS_VB + (size_t)MP * DM * 2);
constexpr size_t WS_OP = alignMiB(WS_GG + (size_t)M * 4096 * 2);
constexpr size_t WS_ABR = alignMiB(WS_OP + (size_t)2 * M * DM * 4);
constexpr size_t WS_MB = alignMiB(WS_ABR + (size_t)M * KBR * 2);
constexpr size_t WS_ACT = WS_OP;
constexpr size_t WS_PP = alignMiB(WS_MB + (size_t)M * DM * 2);
constexpr size_t WS_SSP = alignMiB(WS_PP + (size_t)M * DM * 4);
constexpr size_t WS_END = alignMiB(WS_SSP + (size_t)13 * M * 8 * 4);
constexpr size_t O_YP = 0, O_YS = O_YP + (size_t)MP * DM, O_KP = O_YS + (size_t)MS * DM, O_VP = O_KP + (size_t)DEPTH * MP * DM, O_CP = O_VP + (size_t)DEPTH * MP * DM,
                 O_KS = O_CP + (size_t)DEPTH * NB * 2 * DCONV, O_VS = O_KS + (size_t)DEPTH * MS * DM, O_CS = O_VS + (size_t)DEPTH * MS * DM, O_END = O_CS + (size_t)DEPTH * DB * 2 * DCONV;
static_assert(O_END == 160530432, "output size");
constexpr int CW_BAR = 4096;
constexpr int NSS = 3 * DEPTH + 1;
static_assert((size_t)M * DFF * 2 <= (size_t)2 * M * DM * 4, "ACT fits over OP");

constexpr int RING_OFF = 0, RING_BYTES = 131072;
constexpr int LDSCTL_OFF = 162816, MISC_OFF = LDSCTL_OFF + 320;
constexpr int LDS_SSQ = 131072 + 4096;
constexpr int LDS_BYTES = 163840;
constexpr int NWAVES = 8;

#define GAS __attribute__((address_space(1)))
#define LAS __attribute__((address_space(3)))
typedef unsigned short bf16;
typedef unsigned v4u __attribute__((ext_vector_type(4)));
typedef unsigned v2u __attribute__((ext_vector_type(2)));
typedef float f32x4 __attribute__((ext_vector_type(4)));
#define LDS_WAIT() asm volatile("s_waitcnt lgkmcnt(0)" ::: "memory")
#define VM_WAIT() asm volatile("s_waitcnt vmcnt(0)" ::: "memory")
__device__ __forceinline__ unsigned f2bf(float f) { unsigned u = __builtin_bit_cast(unsigned, f); return (u + 0x7fffu + ((u >> 16) & 1u)) >> 16; }
__device__ __forceinline__ unsigned pk2(float lo, float hi) { return f2bf(lo) | (f2bf(hi) << 16); }
__device__ __forceinline__ float bf_lo(unsigned w) { return __builtin_bit_cast(float, w << 16); }
__device__ __forceinline__ float bf_hi(unsigned w) { return __builtin_bit_cast(float, w & 0xffff0000u); }
__device__ __forceinline__ float wave_sum(float v) {
#define WS_SWZ(K) v += __builtin_bit_cast(float, __builtin_amdgcn_ds_swizzle(__builtin_bit_cast(int, v), ((K) << 10) | 0x1f))
    WS_SWZ(1); WS_SWZ(2); WS_SWZ(4); WS_SWZ(8); WS_SWZ(16);
#undef WS_SWZ
    const unsigned u = __builtin_bit_cast(unsigned, v); unsigned u2 = u; asm volatile("" : "+v"(u2));
    auto rr = __builtin_amdgcn_permlane32_swap(u, u2, false, false);
    const unsigned r0 = rr[0], r1 = rr[1];
    return __uint_as_float(r0) + __uint_as_float(r1);
}
__device__ __forceinline__ float half_sum(float v) {
#define WS_SWZ(K) v += __builtin_bit_cast(float, __builtin_amdgcn_ds_swizzle(__builtin_bit_cast(int, v), ((K) << 10) | 0x1f))
    WS_SWZ(1); WS_SWZ(2); WS_SWZ(4); WS_SWZ(8); WS_SWZ(16);
#undef WS_SWZ
    return v;
}
__device__ __forceinline__ float fast_exp(float x) { return __builtin_amdgcn_exp2f(x * 1.4426950408889634f); }
__device__ __forceinline__ float sigmoidf(float x) { return __builtin_amdgcn_rcpf(1.f + fast_exp(-x)); }
namespace pg8 {
#define PG8_LAS __attribute__((address_space(3)))
typedef unsigned short bf16_t;
typedef short bf16x8 __attribute__((ext_vector_type(8)));
typedef float f32x4 __attribute__((ext_vector_type(4)));
typedef unsigned u32x4 __attribute__((ext_vector_type(4)));
constexpr int BM = 256, BK = 64, HALF = 128, HTB = HALF * BK * 2  , STAGE_BYTES = 8 * HTB, NXCD = 8, WGM = 8;

__host__ __device__ __forceinline__ int lds_byte(int r, int c) { const int st = (r >> 4) * 2 + (c >> 5), rr = r & 15, cc = c & 31, ob = rr * 64 + cc * 2; return st * 1024 + (ob ^ (((ob >> 9) & 1) << 5)); }
__host__ __device__ __forceinline__ void stage_rc(int b, int& R, int& C) { const int st = b / 1024, sb = b % 1024, swz = sb ^ (((sb >> 9) & 1) << 5); R = (st >> 1) * 16 + swz / 64; C = (st & 1) * 32 + (swz % 64) / 2; }
__host__ __device__ __forceinline__ int perm32(int rho) { const int n = rho >> 4, i = rho & 15; return 8 * (i >> 2) + 4 * n + (i & 3); }

struct Unit { int pm, pn, seg; };
struct Gemm { const bf16_t* A; const bf16_t* Bt; int M, N, K; };

struct StaticOrder {
    int nM, nN, nwg, G, c, nseg, srow0;
    __host__ __device__ void init(int M, int N, int G_, int c_, int nseg_ = 1, int srow0_ = 0) { nM = M / BM; nN = N / BM; nwg = nM * nN; G = G_; c = c_; nseg = nseg_; srow0 = srow0_; }
    __host__ __device__ bool next(int i, Unit& u) const {
        const int rnd = nseg == 1 ? i : (i >> 1); u.seg = nseg == 1 ? 0 : (i & 1);
        const long L = (long)rnd * G + c; if (L >= nwg) return false;
        int wgid = (int)L; { const int q = nwg / NXCD, r = nwg % NXCD, xcd = wgid % NXCD, off = wgid / NXCD; wgid = (xcd < r ? xcd * (q + 1) : r * (q + 1) + (xcd - r) * q) + off; }
        const int nig = WGM * nN, gid = wgid / nig, fm = gid * WGM, gsz = (nM - fm) < WGM ? (nM - fm) : WGM;
        u.pm = fm + ((wgid % nig) % gsz); u.pn = (wgid % nig) / gsz; return true;
    }
    __device__ __forceinline__ void a_ready(const Unit&) const {}
    __device__ __forceinline__ void done(const Unit&) const {}
};

typedef unsigned u32x2 __attribute__((ext_vector_type(2)));
__device__ __forceinline__ unsigned cvt_pk_bf16(float lo, float hi) { unsigned r; asm volatile("v_cvt_pk_bf16_f32 %0, %1, %2" : "=v"(r) : "v"(lo), "v"(hi)); return r; }
__device__ __forceinline__ u32x4 pack8(const f32x4& a, const f32x4& b) { u32x4 w; w.x = cvt_pk_bf16(a[0], a[1]); w.y = cvt_pk_bf16(a[2], a[3]); w.z = cvt_pk_bf16(b[0], b[1]); w.w = cvt_pk_bf16(b[2], b[3]); return w; }
__device__ __forceinline__ float ex2(float x) { return __builtin_amdgcn_exp2f(x); }
__device__ __forceinline__ float expneg(float g) { return ex2(fminf(-g * 1.4426950408889634f, 80.f)); }
__device__ __forceinline__ float bflo(unsigned w) { return __builtin_bit_cast(float, w << 16); }
__device__ __forceinline__ float bfhi(unsigned w) { return __builtin_bit_cast(float, w & 0xffff0000u); }

#define PG8_ONE_SEG static __device__ __forceinline__ int k0(int) { return 0; } static __device__ __forceinline__ int nt(int, int K) { return K / BK; } static __device__ __forceinline__ bool final_seg(int) { return true; }
__device__ __forceinline__ float ss_total(const u32x4 a) { return ((bflo(a.x) + bfhi(a.x)) + (bflo(a.y) + bfhi(a.y))) + ((bflo(a.z) + bfhi(a.z)) + (bflo(a.w) + bfhi(a.w))); }
__device__ __forceinline__ float row_rstd(const bf16_t* ss, int row) { const u32x4 a = *(const u32x4*)(ss + (size_t)row * 8);
    return __builtin_amdgcn_rsqf(ss_total(a) * (1.f / 2048.f) + 1e-6f); }
__device__ __forceinline__ bf16_t ss_bf16(float f) { const unsigned u = __builtin_bit_cast(unsigned, f); return (bf16_t)((u + 0x7fffu + ((u >> 16) & 1u)) >> 16); }
__device__ __forceinline__ float fq_sum(float q) {
    q += __builtin_bit_cast(float, __builtin_amdgcn_ds_swizzle(__builtin_bit_cast(int, q), (16 << 10) | 0x1f));
    const unsigned u = __float_as_uint(q); unsigned u2 = u; asm volatile("" : "+v"(u2)); auto rr = __builtin_amdgcn_permlane32_swap(u, u2, false, false); const unsigned r0 = rr[0], r1 = rr[1];
    return __uint_as_float(r0) + __uint_as_float(r1);
}
#define PG8_SS_FINISH __device__ __forceinline__ void finish(const Unit& u, int srow0, int tid) const { \
        asm volatile("s_waitcnt lgkmcnt(0)" ::: "memory"); __builtin_amdgcn_s_barrier(); asm volatile("" ::: "memory"); \
        if (ss) { if (tid < 256) { const float s = (lq[tid] + lq[256 + tid]) + (lq[512 + tid] + lq[768 + tid]); ss[(size_t)(u.pm * BM + tid) * 8 + u.pn] = ss_bf16(s); } \
            else if (tid < 272) { const int r = tid - 256; PG8_LAS const float* p = lq + 1024 + r; const float s = ((p[0] + p[16]) + (p[32] + p[48])) + ((p[64] + p[80]) + (p[96] + p[112])); ss[(size_t)(srow0 + 16 * u.pm + r) * 8 + u.pn] = ss_bf16(s); } } }
#define PG8_NO_FINISH __device__ __forceinline__ void finish(const Unit&, int, int) const {}
struct EpiIn {
    static constexpr bool PERM = true, AFTER_DRAIN = false; PG8_ONE_SEG
    PG8_NO_FINISH
    unsigned char* ws; float* out; int L; const bf16_t* ss;
    __device__ __forceinline__ void mid(f32x4 (&)[2][2][4][2], const Unit&, int, int, int, int) const {}
    __device__ __forceinline__ void operator()(const f32x4 (&acc)[2][2][4][2], const Unit& u, int wr, int wc, int fr, int fq) const {
        const int pn = u.pn, rowt = u.pm * BM + wr * 64 + fr, colw = wc * 32 + 8 * fq;
        float rsv[2][4];
#pragma unroll
        for (int ai = 0; ai < 2; ++ai)
#pragma unroll
            for (int m = 0; m < 4; ++m) rsv[ai][m] = row_rstd(ss, rowt + ai * HALF + m * 16);
        if (pn < 20 || pn >= 36) {
            bf16_t* base; int ld, colt;
            if (pn < 12) { base = (bf16_t*)(ws + WS_ZC); ld = 3072; colt = pn * 256; }
            else if (pn < 20) { base = (bf16_t*)(ws + WS_QB); ld = 2048; colt = (pn - 12) * 256; }
            else { base = (bf16_t*)(ws + WS_GG); ld = 4096; colt = (pn - 36) * 256; }
#pragma unroll
            for (int ai = 0; ai < 2; ++ai)
#pragma unroll
                for (int m = 0; m < 4; ++m) { const int row = rowt + ai * HALF + m * 16; bf16_t* rowp = base + (size_t)row * ld + colt + colw; const float rs = rsv[ai][m];
#pragma unroll
                    for (int bj = 0; bj < 2; ++bj) *(u32x4*)(rowp + bj * HALF) = pack8(acc[ai][bj][m][0] * rs, acc[ai][bj][m][1] * rs); }
        } else {
            const bool isv = pn >= 28; const int colt = (pn - (isv ? 28 : 20)) * 256 + colw;
            float* fbase; bf16_t* bbase;
            if (u.pm < 32) { fbase = out + (isv ? O_VP : O_KP) + (size_t)L * MP * DM; bbase = (bf16_t*)(ws + (isv ? WS_VB : WS_KB)); }
            else { fbase = out + (isv ? O_VS : O_KS) + (size_t)L * MS * DM; bbase = (bf16_t*)(ws + (isv ? WS_VALL : WS_KALL)) + (size_t)L * DB * KROWS * DM; }
#pragma unroll
            for (int ai = 0; ai < 2; ++ai)
#pragma unroll
                for (int m = 0; m < 4; ++m) { const int row = rowt + ai * HALF + m * 16; size_t fo, bo; const float rs = rsv[ai][m];
                    if (u.pm < 32) { fo = (size_t)row * 2048 + colt; bo = fo; }
                    else { const int rs = row - 8192, b = rs >> 6, s = rs & 63; fo = (size_t)rs * 2048 + colt; bo = ((size_t)b * KROWS + 1024 + s) * 2048 + colt; }
#pragma unroll
                    for (int bj = 0; bj < 2; ++bj) { const f32x4 v0 = acc[ai][bj][m][0] * rs, v1 = acc[ai][bj][m][1] * rs; __builtin_nontemporal_store(v0, (f32x4*)(fbase + fo + bj * HALF)); __builtin_nontemporal_store(v1, (f32x4*)(fbase + fo + bj * HALF + 4));
                        *(u32x4*)(bbase + bo + bj * HALF) = pack8(v0, v1); }
                    asm volatile("" ::: "memory"); }
        }
    }
};
struct EpiBr {
    static constexpr bool PERM = true, AFTER_DRAIN = false;
    static __device__ __forceinline__ int k0(int seg) { return seg ? 1024 : 0; }
    static __device__ __forceinline__ int nt(int seg, int) { return seg ? 32 : 16; }
    static __device__ __forceinline__ bool final_seg(int seg) { return seg != 0; }
    PG8_NO_FINISH
    const bf16_t* gg; bf16_t* mb;
    __device__ __forceinline__ void mid(f32x4 (&acc)[2][2][4][2], const Unit& u, int wr, int wc, int fr, int fq) const {
        const int rowt = u.pm * BM + wr * 64 + fr, col0 = u.pn * BM + wc * 32 + 8 * fq;
#define PG8_RATIO(A, B) ((1.f + expneg(B)) * __builtin_amdgcn_rcpf(1.f + expneg(A)))
#pragma unroll
        for (int ai = 0; ai < 2; ++ai) {
            u32x4 ga[4][2], gb[4][2];
#pragma unroll
            for (int m = 0; m < 4; ++m) { const bf16_t* rowp = gg + (size_t)(rowt + ai * HALF + m * 16) * 4096 + col0;
#pragma unroll
                for (int bj = 0; bj < 2; ++bj) { ga[m][bj] = *(const u32x4*)(rowp + bj * HALF); gb[m][bj] = *(const u32x4*)(rowp + 2048 + bj * HALF); } }
            asm volatile("" ::: "memory");
#pragma unroll
            for (int m = 0; m < 4; ++m)
#pragma unroll
                for (int bj = 0; bj < 2; ++bj) { const u32x4 a = ga[m][bj], b = gb[m][bj];
                    acc[ai][bj][m][0][0] *= PG8_RATIO(bflo(a.x), bflo(b.x)); acc[ai][bj][m][0][1] *= PG8_RATIO(bfhi(a.x), bfhi(b.x));
                    acc[ai][bj][m][0][2] *= PG8_RATIO(bflo(a.y), bflo(b.y)); acc[ai][bj][m][0][3] *= PG8_RATIO(bfhi(a.y), bfhi(b.y));
                    acc[ai][bj][m][1][0] *= PG8_RATIO(bflo(a.z), bflo(b.z)); acc[ai][bj][m][1][1] *= PG8_RATIO(bfhi(a.z), bfhi(b.z));
                    acc[ai][bj][m][1][2] *= PG8_RATIO(bflo(a.w), bflo(b.w)); acc[ai][bj][m][1][3] *= PG8_RATIO(bfhi(a.w), bfhi(b.w)); }
            asm volatile("" ::: "memory");
        }
#undef PG8_RATIO
    }
    __device__ __forceinline__ void operator()(const f32x4 (&acc)[2][2][4][2], const Unit& u, int wr, int wc, int fr, int fq) const {
        const int rowt = u.pm * BM + wr * 64 + fr, col0 = u.pn * BM + wc * 32 + 8 * fq;
#define PG8_SB(B) __builtin_amdgcn_rcpf(1.f + expneg(B))
        u32x4 gb[2][4][2];
#pragma unroll
        for (int ai = 0; ai < 2; ++ai)
#pragma unroll
            for (int m = 0; m < 4; ++m)
#pragma unroll
                for (int bj = 0; bj < 2; ++bj) gb[ai][m][bj] = *(const u32x4*)(gg + (size_t)(rowt + ai * HALF + m * 16) * 4096 + 2048 + col0 + bj * HALF);
        asm volatile("" ::: "memory");
#pragma unroll
        for (int ai = 0; ai < 2; ++ai)
#pragma unroll
            for (int m = 0; m < 4; ++m) { const size_t r = (size_t)(rowt + ai * HALF + m * 16);
#pragma unroll
                for (int bj = 0; bj < 2; ++bj) { const u32x4 b = gb[ai][m][bj];
                    f32x4 v0 = acc[ai][bj][m][0], v1 = acc[ai][bj][m][1];
                    v0[0] *= PG8_SB(bflo(b.x)); v0[1] *= PG8_SB(bfhi(b.x)); v0[2] *= PG8_SB(bflo(b.y)); v0[3] *= PG8_SB(bfhi(b.y));
                    v1[0] *= PG8_SB(bflo(b.z)); v1[1] *= PG8_SB(bfhi(b.z)); v1[2] *= PG8_SB(bflo(b.w)); v1[3] *= PG8_SB(bfhi(b.w));
                    *(u32x4*)(mb + r * 2048 + col0 + bj * HALF) = pack8(v0, v1); } }
#undef PG8_SB
    }
    __device__ __forceinline__ void sliver_mid(f32x4 (&accs)[2], const Unit& u, int srow0, int wr, int wc, int fr, int fq) const {
        const size_t r = (size_t)(srow0 + 16 * u.pm + fr); const int col0 = u.pn * BM + wr * HALF + wc * 32 + 8 * fq;
        const u32x4 a = *(const u32x4*)(gg + r * 4096 + col0), b = *(const u32x4*)(gg + r * 4096 + 2048 + col0);
#define PG8_RATIO(A, B) ((1.f + expneg(B)) * __builtin_amdgcn_rcpf(1.f + expneg(A)))
        accs[0][0] *= PG8_RATIO(bflo(a.x), bflo(b.x)); accs[0][1] *= PG8_RATIO(bfhi(a.x), bfhi(b.x)); accs[0][2] *= PG8_RATIO(bflo(a.y), bflo(b.y)); accs[0][3] *= PG8_RATIO(bfhi(a.y), bfhi(b.y));
        accs[1][0] *= PG8_RATIO(bflo(a.z), bflo(b.z)); accs[1][1] *= PG8_RATIO(bfhi(a.z), bfhi(b.z)); accs[1][2] *= PG8_RATIO(bflo(a.w), bflo(b.w)); accs[1][3] *= PG8_RATIO(bfhi(a.w), bfhi(b.w));
#undef PG8_RATIO
    }
    __device__ __forceinline__ void sliver(const f32x4 (&accs)[2], const Unit& u, int srow0, int wr, int wc, int fr, int fq) const {
        const size_t r = (size_t)(srow0 + 16 * u.pm + fr); const int col0 = u.pn * BM + wr * HALF + wc * 32 + 8 * fq;
        const u32x4 b = *(const u32x4*)(gg + r * 4096 + 2048 + col0);
#define PG8_SB(B) __builtin_amdgcn_rcpf(1.f + expneg(B))
        f32x4 v0 = accs[0], v1 = accs[1];
        v0[0] *= PG8_SB(bflo(b.x)); v0[1] *= PG8_SB(bfhi(b.x)); v0[2] *= PG8_SB(bflo(b.y)); v0[3] *= PG8_SB(bfhi(b.y));
        v1[0] *= PG8_SB(bflo(b.z)); v1[1] *= PG8_SB(bfhi(b.z)); v1[2] *= PG8_SB(bflo(b.w)); v1[3] *= PG8_SB(bfhi(b.w));
#undef PG8_SB
        *(u32x4*)(mb + r * 2048 + col0) = pack8(v0, v1);
    }
};
__device__ __forceinline__ void norm_out(const f32x4& o, const float* gain, bf16_t* dst, size_t doff, int col, float& q) {
    q += (o[0] * o[0] + o[1] * o[1]) + (o[2] * o[2] + o[3] * o[3]);
    const f32x4 g = *(const f32x4*)(gain + col); u32x2 w; w.x = cvt_pk_bf16(o[0] * g[0], o[1] * g[1]); w.y = cvt_pk_bf16(o[2] * g[2], o[3] * g[3]);
    *(u32x2*)(dst + doff + col) = w;
}
template <bool DST> struct EpiResT {
    static constexpr bool PERM = true, AFTER_DRAIN = false; PG8_ONE_SEG
    bf16_t* X; const float* gain; bf16_t* dst; int ldd, dcol; bf16_t* ss; PG8_LAS float* lq;
    __device__ __forceinline__ void mid(f32x4 (&)[2][2][4][2], const Unit&, int, int, int, int) const {}
    __device__ __forceinline__ void operator()(const f32x4 (&acc)[2][2][4][2], const Unit& u, int wr, int wc, int fr, int fq) const {
        const int rowt = u.pm * BM + wr * 64 + fr, col0 = u.pn * BM + wc * 32 + 8 * fq;
        f32x4 gv[2][2];
#pragma unroll
        for (int bj = 0; bj < 2; ++bj)
#pragma unroll
            for (int n = 0; n < 2; ++n) gv[bj][n] = DST ? *(const f32x4*)(gain + col0 + bj * HALF + n * 4) : (f32x4){0.f, 0.f, 0.f, 0.f};
#pragma unroll
        for (int ai = 0; ai < 2; ++ai) {
            u32x4 xv[4][2];
#pragma unroll
            for (int m = 0; m < 4; ++m)
#pragma unroll
                for (int bj = 0; bj < 2; ++bj) xv[m][bj] = *(const u32x4*)(X + (size_t)(rowt + ai * HALF + m * 16) * 2048 + col0 + bj * HALF);
            asm volatile("" ::: "memory");
#pragma unroll
            for (int m = 0; m < 4; ++m) { const int row = rowt + ai * HALF + m * 16; float q = 0.f;
#pragma unroll
                for (int bj = 0; bj < 2; ++bj) { const int col = col0 + bj * HALF; const u32x4 xw = xv[m][bj];
                    const f32x4 o0 = (f32x4){bflo(xw.x), bfhi(xw.x), bflo(xw.y), bfhi(xw.y)} + acc[ai][bj][m][0], o1 = (f32x4){bflo(xw.z), bfhi(xw.z), bflo(xw.w), bfhi(xw.w)} + acc[ai][bj][m][1];
                    *(u32x4*)(X + (size_t)row * 2048 + col) = pack8(o0, o1);
                    q += ((o0[0] * o0[0] + o0[1] * o0[1]) + (o0[2] * o0[2] + o0[3] * o0[3])) + ((o1[0] * o1[0] + o1[1] * o1[1]) + (o1[2] * o1[2] + o1[3] * o1[3]));
                    if constexpr (DST) *(u32x4*)(dst + (size_t)row * ldd + dcol + col) = pack8(o0 * gv[bj][0], o1 * gv[bj][1]); }
                q = fq_sum(q); if (fq == 0) lq[wc * 256 + ai * HALF + wr * 64 + m * 16 + fr] = q; }
            asm volatile("" ::: "memory");
        }
    }
    __device__ __forceinline__ void sliver_mid(f32x4 (&)[2], const Unit&, int, int, int, int, int) const {}
    __device__ __forceinline__ void sliver(const f32x4 (&accs)[2], const Unit& u, int srow0, int wr, int wc, int fr, int fq) const {
        const int row = srow0 + 16 * u.pm + fr, col = u.pn * BM + wr * HALF + wc * 32 + 8 * fq;
        const u32x4 xw = *(const u32x4*)(X + (size_t)row * 2048 + col);
        const f32x4 o0 = (f32x4){bflo(xw.x), bfhi(xw.x), bflo(xw.y), bfhi(xw.y)} + accs[0], o1 = (f32x4){bflo(xw.z), bfhi(xw.z), bflo(xw.w), bfhi(xw.w)} + accs[1];
        *(u32x4*)(X + (size_t)row * 2048 + col) = pack8(o0, o1);
        float q = ((o0[0] * o0[0] + o0[1] * o0[1]) + (o0[2] * o0[2] + o0[3] * o0[3])) + ((o1[0] * o1[0] + o1[1] * o1[1]) + (o1[2] * o1[2] + o1[3] * o1[3]));
        if constexpr (DST) { const f32x4 g0 = *(const f32x4*)(gain + col), g1 = *(const f32x4*)(gain + col + 4); *(u32x4*)(dst + (size_t)row * ldd + dcol + col) = pack8(o0 * g0, o1 * g1); }
        q = fq_sum(q); if (fq == 0) lq[1024 + (wr * 4 + wc) * 16 + fr] = q;
    }
    PG8_SS_FINISH
};
struct EpiUp {
    static constexpr bool PERM = true, AFTER_DRAIN = false; PG8_ONE_SEG
    PG8_NO_FINISH
    bf16_t* act; const bf16_t* ss;
    __device__ __forceinline__ void mid(f32x4 (&)[2][2][4][2], const Unit&, int, int, int, int) const {}
    __device__ __forceinline__ void operator()(const f32x4 (&acc)[2][2][4][2], const Unit& u, int wr, int wc, int fr, int fq) const {
        const int rowt = u.pm * BM + wr * 64 + fr, col0 = u.pn * HALF + wc * 32 + 8 * fq;
        float rsv[2][4];
#pragma unroll
        for (int ai = 0; ai < 2; ++ai)
#pragma unroll
            for (int m = 0; m < 4; ++m) rsv[ai][m] = row_rstd(ss, rowt + ai * HALF + m * 16);
#pragma unroll
        for (int ai = 0; ai < 2; ++ai)
#pragma unroll
            for (int m = 0; m < 4; ++m) { f32x4 v[2]; const float rs = rsv[ai][m];
#pragma unroll
                for (int n = 0; n < 2; ++n)
#pragma unroll
                    for (int i = 0; i < 4; ++i) { const float g = acc[ai][0][m][n][i] * rs; v[n][i] = g * __builtin_amdgcn_rcpf(1.f + expneg(g)) * (acc[ai][1][m][n][i] * rs); }
                *(u32x4*)(act + (size_t)(rowt + ai * HALF + m * 16) * 5632 + col0) = pack8(v[0], v[1]); }
    }
};
struct EpiPle {
    static constexpr bool PERM = true, AFTER_DRAIN = false;
    static __device__ __forceinline__ int k0(int seg) { return seg ? 256 : 0; }
    static __device__ __forceinline__ int nt(int seg, int) { return seg ? 32 : 4; }
    static __device__ __forceinline__ bool final_seg(int seg) { return seg != 0; }
    bf16_t* X; bf16_t* PP; const bf16_t* ss3; const float* gain; bf16_t* dst; bf16_t* ss; PG8_LAS float* lq;
    __device__ __forceinline__ void mid(f32x4 (&acc)[2][2][4][2], const Unit& u, int wr, int wc, int fr, int fq) const {
        const int rowt = u.pm * BM + wr * 64 + fr, col0 = u.pn * BM + wc * 32 + 8 * fq;
#pragma unroll
        for (int ai = 0; ai < 2; ++ai)
#pragma unroll
            for (int m = 0; m < 4; ++m) { bf16_t* rowp = PP + (size_t)(rowt + ai * HALF + m * 16) * 2048 + col0;
#pragma unroll
                for (int bj = 0; bj < 2; ++bj) { *(u32x4*)(rowp + bj * HALF) = pack8(acc[ai][bj][m][0], acc[ai][bj][m][1]); acc[ai][bj][m][0] = (f32x4){0.f, 0.f, 0.f, 0.f}; acc[ai][bj][m][1] = (f32x4){0.f, 0.f, 0.f, 0.f}; } }
    }
    __device__ __forceinline__ void operator()(const f32x4 (&acc)[2][2][4][2], const Unit& u, int wr, int wc, int fr, int fq) const {
        const int rowt = u.pm * BM + wr * 64 + fr, col0 = u.pn * BM + wc * 32 + 8 * fq;
        f32x4 gv[2][2];
#pragma unroll
        for (int bj = 0; bj < 2; ++bj)
#pragma unroll
            for (int n = 0; n < 2; ++n) gv[bj][n] = (f32x4){0.f, 0.f, 0.f, 0.f};
#pragma unroll
        for (int ai = 0; ai < 2; ++ai)
#pragma unroll
            for (int mh = 0; mh < 2; ++mh) {
                u32x4 xv[2][2], pv[2][2]; u32x4 sa[2];
#pragma unroll
                for (int m2 = 0; m2 < 2; ++m2) { const int row = rowt + ai * HALF + (mh * 2 + m2) * 16; sa[m2] = *(const u32x4*)(ss3 + (size_t)row * 8);
#pragma unroll
                    for (int bj = 0; bj < 2; ++bj) { const size_t o_ = (size_t)row * 2048 + col0 + bj * HALF; xv[m2][bj] = *(const u32x4*)(X + o_); pv[m2][bj] = *(const u32x4*)(PP + o_); } }
                asm volatile("" ::: "memory");
#pragma unroll
                for (int m2 = 0; m2 < 2; ++m2) { const int m = mh * 2 + m2, row = rowt + ai * HALF + m * 16; float q = 0.f;
                    const float rs = __builtin_amdgcn_rsqf(ss_total(sa[m2]) * (1.f / 2048.f) + 1e-6f);
#pragma unroll
                    for (int bj = 0; bj < 2; ++bj) { const int col = col0 + bj * HALF; const u32x4 xw = xv[m2][bj], pw = pv[m2][bj];
                        const f32x4 x0 = {bflo(xw.x), bfhi(xw.x), bflo(xw.y), bfhi(xw.y)}, x1 = {bflo(xw.z), bfhi(xw.z), bflo(xw.w), bfhi(xw.w)};
                        const f32x4 p0 = {bflo(pw.x), bfhi(pw.x), bflo(pw.y), bfhi(pw.y)}, p1 = {bflo(pw.z), bfhi(pw.z), bflo(pw.w), bfhi(pw.w)};
                        const f32x4 a0 = acc[ai][bj][m][0], a1 = acc[ai][bj][m][1]; f32x4 o0, o1;
#pragma unroll
                        for (int i = 0; i < 4; ++i) { o0[i] = x0[i] + p0[i] * __builtin_amdgcn_rcpf(1.f + expneg(a0[i] * rs)); o1[i] = x1[i] + p1[i] * __builtin_amdgcn_rcpf(1.f + expneg(a1[i] * rs)); }
                        *(u32x4*)(X + (size_t)row * 2048 + col) = pack8(o0, o1);
                        if (gain) q += ((o0[0] * o0[0] + o0[1] * o0[1]) + (o0[2] * o0[2] + o0[3] * o0[3])) + ((o1[0] * o1[0] + o1[1] * o1[1]) + (o1[2] * o1[2] + o1[3] * o1[3])); }
                    if (gain) { q = fq_sum(q); if (fq == 0) lq[wc * 256 + ai * HALF + wr * 64 + m * 16 + fr] = q; } }
                asm volatile("" ::: "memory");
            }
    }
    __device__ __forceinline__ void sliver_mid(f32x4 (&accs)[2], const Unit& u, int srow0, int wr, int wc, int fr, int fq) const {
        bf16_t* rowp = PP + (size_t)(srow0 + 16 * u.pm + fr) * 2048 + u.pn * BM + wr * HALF + wc * 32 + 8 * fq;
        *(u32x4*)rowp = pack8(accs[0], accs[1]); accs[0] = (f32x4){0.f, 0.f, 0.f, 0.f}; accs[1] = (f32x4){0.f, 0.f, 0.f, 0.f};
    }
    __device__ __forceinline__ void sliver(const f32x4 (&accs)[2], const Unit& u, int srow0, int wr, int wc, int fr, int fq) const {
        const int row = srow0 + 16 * u.pm + fr, col = u.pn * BM + wr * HALF + wc * 32 + 8 * fq; const size_t off = (size_t)row * 2048 + col; const float rs = row_rstd(ss3, row);
        const u32x4 xw = *(const u32x4*)(X + off), pw = *(const u32x4*)(PP + off);
        const f32x4 x0 = {bflo(xw.x), bfhi(xw.x), bflo(xw.y), bfhi(xw.y)}, x1 = {bflo(xw.z), bfhi(xw.z), bflo(xw.w), bfhi(xw.w)};
        const f32x4 p0 = {bflo(pw.x), bfhi(pw.x), bflo(pw.y), bfhi(pw.y)}, p1 = {bflo(pw.z), bfhi(pw.z), bflo(pw.w), bfhi(pw.w)}; f32x4 o0, o1;
#pragma unroll
        for (int i = 0; i < 4; ++i) { o0[i] = x0[i] + p0[i] * __builtin_amdgcn_rcpf(1.f + expneg(accs[0][i] * rs)); o1[i] = x1[i] + p1[i] * __builtin_amdgcn_rcpf(1.f + expneg(accs[1][i] * rs)); }
        *(u32x4*)(X + off) = pack8(o0, o1);
        if (gain) { float q = ((o0[0] * o0[0] + o0[1] * o0[1]) + (o0[2] * o0[2] + o0[3] * o0[3])) + ((o1[0] * o1[0] + o1[1] * o1[1]) + (o1[2] * o1[2] + o1[3] * o1[3]));
            q = fq_sum(q); if (fq == 0) lq[1024 + (wr * 4 + wc) * 16 + fr] = q; }
    }
    PG8_SS_FINISH
};
template <class Epi, class Sched, bool ALIGN_EPI = false, bool SP2 = false, bool SLIVER = false>
__device__ __forceinline__ void gemm_phase(PG8_LAS unsigned char* lds, const Gemm g, const Sched& S, const Epi& E) {
    int tid_ = threadIdx.x; asm volatile("" : "+v"(tid_));
    const int tid = tid_, wid = __builtin_amdgcn_readfirstlane(tid >> 6), lane = tid & 63, wr = wid >> 2, wc = wid & 3, fr = lane & 15, fq = lane >> 4;
    const int K = g.K;
    unsigned voffA[2], voffB[2];
#pragma unroll
    for (int i = 0; i < 2; ++i) { int R, C; stage_rc(tid * 16 + i * 8192, R, C); const int Rb = Epi::PERM ? ((R & ~31) + perm32(R & 31)) : R;
        voffA[i] = (unsigned)(R * K + C) * 2u; voffB[i] = (unsigned)(Rb * K + C) * 2u; }
    const size_t kstep = (size_t)(BK * 2);
    const size_t qstep = (size_t)64 * K * 2;
    const size_t hstep = (size_t)HALF * K * 2;
    const size_t tstep = 2 * hstep;
    const unsigned ldsw = (unsigned)wid * 1024u;
    const int aoff = lds_byte(wr * 64 + fr, fq * 8), boff = lds_byte(wc * 32 + fr, fq * 8);
    static_assert(!SLIVER || SP2, "the sliver is built into the SP2 loop only");
    const int sp_ = wid * 64 + lane, srow_ = sp_ >> 5, sch_ = ((sp_ & 31) >> 2) ^ (srow_ & 7);
    const unsigned voffS = (unsigned)(srow_ * K) * 2u + (unsigned)(sch_ * 16 + (sp_ & 3) * 4);
    const int soff0 = fr * 128 + 16 * (fq ^ (fr & 7));
#define PG8_SA(b, h) (((b) * 2 + (h)) * HTB)
#define PG8_SB(b, h) ((4 + (b) * 2 + (h)) * HTB)
#define PG8_STAGE(bufoff, gbase, voff) do { _Pragma("unroll") for (int _i = 0; _i < 2; ++_i) \
        __builtin_amdgcn_global_load_lds((const unsigned*)((const char*)(gbase) + (size_t)_i * qstep + (voff)[0]), (PG8_LAS unsigned*)(lds + (bufoff) + ldsw + _i * 8192), 16, 0, 0); } while (0)
#define PG8_LDA(dst, b, h) do { _Pragma("unroll") for (int m = 0; m < 4; ++m) _Pragma("unroll") for (int k = 0; k < 2; ++k) dst[m][k] = *(const PG8_LAS bf16x8*)(lds + PG8_SA(b, h) + aoff + m * 2048 + k * 1024); } while (0)
#define PG8_LDB(dst, b, h) do { _Pragma("unroll") for (int n = 0; n < 2; ++n) _Pragma("unroll") for (int k = 0; k < 2; ++k) dst[n][k] = *(const PG8_LAS bf16x8*)(lds + PG8_SB(b, h) + boff + n * 2048 + k * 1024); } while (0)
#define PG8_MMA(ai, bj, At, Bt) do { __builtin_amdgcn_s_setprio(1); _Pragma("unroll") for (int m = 0; m < 4; ++m) _Pragma("unroll") for (int n = 0; n < 2; ++n) _Pragma("unroll") for (int k = 0; k < 2; ++k) \
        acc[ai][bj][m][n] = __builtin_amdgcn_mfma_f32_16x16x32_bf16(Bt[n][k], At[m][k], acc[ai][bj][m][n], 0, 0, 0); __builtin_amdgcn_s_setprio(0); } while (0)
#define PG8_WAIT_V(n) asm volatile("s_waitcnt vmcnt(" #n ")" ::: "memory")
#define PG8_WAIT_V89() do { if constexpr (SLIVER) PG8_WAIT_V(9); else PG8_WAIT_V(8); } while (0)
#define PG8_STAGE_S(b, gbase) do { if constexpr (SLIVER) __builtin_amdgcn_global_load_lds((const unsigned*)((const char*)(gbase) + voffS), (PG8_LAS unsigned*)(lds + STAGE_BYTES + (b) * 2048 + wid * 256), 4, 0, 0); } while (0)
#define PG8_LDS_S(b) do { if constexpr (SLIVER) { Sf[0] = *(const PG8_LAS bf16x8*)(lds + STAGE_BYTES + (b) * 2048 + soff0); Sf[1] = *(const PG8_LAS bf16x8*)(lds + STAGE_BYTES + (b) * 2048 + (soff0 ^ 64)); } } while (0)
#define PG8_MMA_S() do { if constexpr (SLIVER) { __builtin_amdgcn_s_setprio(1); if (wr == 0) { _Pragma("unroll") for (int n = 0; n < 2; ++n) _Pragma("unroll") for (int k = 0; k < 2; ++k) accs[n] = __builtin_amdgcn_mfma_f32_16x16x32_bf16(B0[n][k], Sf[k], accs[n], 0, 0, 0); } \
        else { _Pragma("unroll") for (int n = 0; n < 2; ++n) _Pragma("unroll") for (int k = 0; k < 2; ++k) accs[n] = __builtin_amdgcn_mfma_f32_16x16x32_bf16(B1[n][k], Sf[k], accs[n], 0, 0, 0); } __builtin_amdgcn_s_setprio(0); } } while (0)
#define PG8_WAIT_L(n) asm volatile("s_waitcnt lgkmcnt(" #n ")" ::: "memory")
#define PG8_BAR __builtin_amdgcn_s_barrier()
#define PG8_SCHED __builtin_amdgcn_sched_barrier(0)
    Unit cur, nxt; int ui = 0;
    if (!S.next(0, cur)) return;
    f32x4 acc[2][2][4][2];
#pragma unroll
    for (int a = 0; a < 2; ++a)
#pragma unroll
        for (int b = 0; b < 2; ++b)
#pragma unroll
            for (int m = 0; m < 4; ++m)
#pragma unroll
                for (int n = 0; n < 2; ++n) acc[a][b][m][n] = (f32x4){0.f, 0.f, 0.f, 0.f};
    bf16x8 At[4][2], B0[2][2], B1[2][2], Sf[2];
    f32x4 accs[2] = {(f32x4){0.f, 0.f, 0.f, 0.f}, (f32x4){0.f, 0.f, 0.f, 0.f}};
    const char* cA = (const char*)g.A + (size_t)cur.pm * tstep + Epi::k0(cur.seg) * 2; const char* cB = (const char*)g.Bt + (size_t)cur.pn * tstep + Epi::k0(cur.seg) * 2;
    int nt = Epi::nt(cur.seg, K);
    const size_t sstep = (size_t)16 * K * 2;
    const char* cS = (const char*)g.A + (size_t)S.srow0 * K * 2 + (size_t)cur.pm * sstep + Epi::k0(cur.seg) * 2;
    S.a_ready(cur);
    if constexpr (SP2) {
        PG8_STAGE(PG8_SB(0, 0), cB, voffB); PG8_STAGE(PG8_SB(0, 1), cB + hstep, voffB); PG8_STAGE(PG8_SA(0, 0), cA, voffA); PG8_STAGE(PG8_SA(0, 1), cA + hstep, voffA); PG8_STAGE_S(0, cS);
        if (wr == 1) PG8_BAR;
        if constexpr (SLIVER) PG8_WAIT_V(3); else PG8_WAIT_V(2);
        PG8_BAR;
        PG8_STAGE(PG8_SB(1, 0), cB + kstep, voffB); PG8_STAGE(PG8_SA(1, 0), cA + kstep, voffA); PG8_STAGE(PG8_SB(1, 1), cB + hstep + kstep, voffB);
        PG8_WAIT_V(6); PG8_BAR;
    } else {
        PG8_STAGE(PG8_SB(0, 0), cB, voffB); PG8_STAGE(PG8_SA(0, 0), cA, voffA); PG8_STAGE(PG8_SB(0, 1), cB + hstep, voffB); PG8_STAGE(PG8_SA(0, 1), cA + hstep, voffA);
        if (wr == 1) PG8_BAR;
        PG8_WAIT_V(4); PG8_BAR;
        PG8_STAGE(PG8_SB(1, 0), cB + kstep, voffB); PG8_STAGE(PG8_SA(1, 0), cA + kstep, voffA); PG8_STAGE(PG8_SB(1, 1), cB + hstep + kstep, voffB);
        PG8_WAIT_V(6); PG8_BAR;
    }
    for (;;) {
        const bool has_next = S.next(ui + 1, nxt);
        const char* nA = has_next ? (const char*)g.A + (size_t)nxt.pm * tstep + Epi::k0(nxt.seg) * 2 : cA; const char* nB = has_next ? (const char*)g.Bt + (size_t)nxt.pn * tstep + Epi::k0(nxt.seg) * 2 : cB;
        const char* nS = has_next ? (const char*)g.A + (size_t)S.srow0 * K * 2 + (size_t)nxt.pm * sstep + Epi::k0(nxt.seg) * 2 : cS;
        for (int t = 0; t < nt; t += 2) {
            const bool last = (t == nt - 2);
            const char* a1 = cA + (size_t)(t + 1) * kstep;
            const char* a2 = last ? nA : cA + (size_t)(t + 2) * kstep; const char* b2 = last ? nB : cB + (size_t)(t + 2) * kstep;
            const char* a3 = a2 + kstep; const char* b3 = b2 + kstep;
            const char* s1 = cS + (size_t)(t + 1) * kstep; const char* s2 = last ? nS : cS + (size_t)(t + 2) * kstep;
            if (last && has_next) S.a_ready(nxt);
            if constexpr (SP2) {
            PG8_LDB(B0, 0, 0); PG8_LDB(B1, 0, 1); PG8_SCHED; PG8_LDA(At, 0, 0); PG8_STAGE(PG8_SA(1, 1), a1 + hstep, voffA); PG8_STAGE_S(1, s1);
            PG8_WAIT_V89(); PG8_WAIT_L(0); PG8_BAR; PG8_MMA(0, 0, At, B0); PG8_MMA(0, 1, At, B1); PG8_BAR; PG8_SCHED;
            PG8_LDA(At, 0, 1); PG8_LDS_S(0); PG8_STAGE(PG8_SB(0, 0), b2, voffB); PG8_STAGE(PG8_SB(0, 1), b2 + hstep, voffB); PG8_STAGE(PG8_SA(0, 0), a2, voffA);
            PG8_WAIT_V89(); PG8_WAIT_L(0); PG8_BAR; PG8_MMA(1, 0, At, B0); PG8_MMA(1, 1, At, B1); PG8_MMA_S(); PG8_BAR; PG8_SCHED;
            PG8_LDB(B0, 1, 0); PG8_LDB(B1, 1, 1); PG8_SCHED; PG8_LDA(At, 1, 0); PG8_STAGE(PG8_SA(0, 1), a2 + hstep, voffA); PG8_STAGE_S(0, s2);
            PG8_WAIT_V89(); PG8_WAIT_L(0); PG8_BAR; PG8_MMA(0, 0, At, B0); PG8_MMA(0, 1, At, B1); PG8_BAR; PG8_SCHED;
            PG8_LDA(At, 1, 1); PG8_LDS_S(1); PG8_STAGE(PG8_SB(1, 0), b3, voffB); PG8_STAGE(PG8_SB(1, 1), b3 + hstep, voffB); PG8_STAGE(PG8_SA(1, 0), a3, voffA);
            PG8_WAIT_V89(); PG8_WAIT_L(0); PG8_BAR; PG8_MMA(1, 0, At, B0); PG8_MMA(1, 1, At, B1); PG8_MMA_S(); PG8_BAR; PG8_SCHED;
            } else {
            PG8_LDB(B0, 0, 0); PG8_SCHED; PG8_LDA(At, 0, 0); PG8_STAGE(PG8_SA(1, 1), a1 + hstep, voffA);
            PG8_WAIT_L(8); PG8_BAR; PG8_WAIT_L(0); PG8_MMA(0, 0, At, B0); PG8_BAR; PG8_SCHED;
            PG8_LDB(B1, 0, 1); PG8_STAGE(PG8_SB(0, 0), b2, voffB);
            PG8_BAR; PG8_WAIT_L(0); PG8_MMA(0, 1, At, B1); PG8_BAR;
            PG8_LDA(At, 0, 1); PG8_STAGE(PG8_SA(0, 0), a2, voffA);
            PG8_BAR; PG8_WAIT_L(0); PG8_MMA(1, 0, At, B0); PG8_BAR; PG8_SCHED;
            PG8_STAGE(PG8_SB(0, 1), b2 + hstep, voffB);
            PG8_WAIT_V(6); PG8_BAR; PG8_MMA(1, 1, At, B1); PG8_BAR;
            PG8_LDB(B0, 1, 0); PG8_SCHED; PG8_LDA(At, 1, 0); PG8_STAGE(PG8_SA(0, 1), a2 + hstep, voffA);
            PG8_WAIT_L(8); PG8_BAR; PG8_WAIT_L(0); PG8_MMA(0, 0, At, B0); PG8_BAR; PG8_SCHED;
            PG8_LDB(B1, 1, 1); PG8_STAGE(PG8_SB(1, 0), b3, voffB);
            PG8_BAR; PG8_WAIT_L(0); PG8_MMA(0, 1, At, B1); PG8_BAR;
            PG8_LDA(At, 1, 1); PG8_STAGE(PG8_SA(1, 0), a3, voffA);
            PG8_BAR; PG8_WAIT_L(0); PG8_MMA(1, 0, At, B0); PG8_BAR; PG8_SCHED;
            PG8_STAGE(PG8_SB(1, 1), b3 + hstep, voffB);
            PG8_WAIT_V(6); PG8_BAR; PG8_MMA(1, 1, At, B1); PG8_BAR;
            }
        }
        if constexpr (ALIGN_EPI) { if (wr == 0) PG8_BAR; }
        const bool fin = Epi::final_seg(cur.seg);
        if constexpr (!Epi::AFTER_DRAIN) { int l2_ = threadIdx.x; asm volatile("" : "+v"(l2_)); const int fr2 = l2_ & 15, fq2 = (l2_ >> 4) & 3;
            if (fin) { E(acc, cur, wr, wc, fr2, fq2); if constexpr (SLIVER) E.sliver(accs, cur, S.srow0, wr, wc, fr2, fq2); E.finish(cur, S.srow0, l2_); } else { E.mid(acc, cur, wr, wc, fr2, fq2); if constexpr (SLIVER) E.sliver_mid(accs, cur, S.srow0, wr, wc, fr2, fq2); } S.done(cur); }
        if (!has_next) break;
        if (fin) {
#pragma unroll
        for (int a = 0; a < 2; ++a)
#pragma unroll
            for (int b = 0; b < 2; ++b)
#pragma unroll
                for (int m = 0; m < 4; ++m)
#pragma unroll
                    for (int n = 0; n < 2; ++n) acc[a][b][m][n] = (f32x4){0.f, 0.f, 0.f, 0.f};
        accs[0] = (f32x4){0.f, 0.f, 0.f, 0.f}; accs[1] = (f32x4){0.f, 0.f, 0.f, 0.f};
        }
        cur = nxt; cA = nA; cB = nB; cS = nS; nt = Epi::nt(cur.seg, K); ++ui;
        if constexpr (ALIGN_EPI) { if (wr == 1) PG8_BAR; }
    }
    PG8_WAIT_V(0);
    if constexpr (!ALIGN_EPI) { if (wr == 0) PG8_BAR; }
    PG8_BAR;
    if constexpr (Epi::AFTER_DRAIN) { E.fused(acc, cur, wr, wc, fr, fq, lds, wid, lane); S.done(cur); }
#undef PG8_SA
#undef PG8_SB
#undef PG8_STAGE
#undef PG8_LDA
#undef PG8_LDB
#undef PG8_MMA
#undef PG8_WAIT_V
#undef PG8_WAIT_V89
#undef PG8_STAGE_S
#undef PG8_LDS_S
#undef PG8_MMA_S
#undef PG8_WAIT_L
#undef PG8_BAR
#undef PG8_SCHED
}
}
namespace att {
using bf16x8 = __attribute__((ext_vector_type(8))) short;
using s16x4  = __attribute__((ext_vector_type(4))) short;
using f32x16 = __attribute__((ext_vector_type(16))) float;
using u32x4  = __attribute__((ext_vector_type(4))) unsigned;
typedef unsigned short bf16_t;
constexpr int D = 128, NW = 8, QBLK = 32, KVBLK = 64, LD = 2048;
#ifndef ATT_SDEPTH
#define ATT_SDEPTH 1
#endif
constexpr int SDEPTH = ATT_SDEPTH;
constexpr float SCALE = 0.088388347648318440f, LOG2E = 1.4426950408889634f, C = SCALE * LOG2E;
constexpr float THR2 = 8.f * LOG2E;
constexpr size_t SHM_V = KVBLK * D * 2, SHM_K = KVBLK * D * 2;
constexpr int OFF_WS = 2 * SHM_V + 2 * SHM_K, OFF_TAB = OFF_WS + NW * 64 * 4, NTAB = 160, OFF_Q = OFF_TAB + NTAB * 4, SHM_ATTN = OFF_Q + NW * 8192;
#define KSWZ(row, colB) ((row) * 256 + ((colB) ^ (((row) & 7) << 4)))
#define SBAR() __builtin_amdgcn_sched_barrier(0)
__device__ __forceinline__ int crow(int r, int hi) { return (r & 3) + 8 * (r >> 2) + 4 * hi; }
__device__ __forceinline__ unsigned cvtpk(float lo, float hi) { unsigned r; asm volatile("v_cvt_pk_bf16_f32 %0, %1, %2" : "=v"(r) : "v"(lo), "v"(hi)); return r; }

struct WaveInfo { int ntw; int qpos; float cfar; };

__device__ __forceinline__ void partialSM(f32x16& p0, f32x16& p1, float& m_reg, float& mn, float& alpha, int t, const WaveInfo& wi, const float* tab, int hi) {
  if (t >= wi.ntw) {
#pragma unroll
    for (int r = 0; r < 16; ++r) { p0[r] = -1e30f; p1[r] = -1e30f; }
  } else {
    const int dbase = 64 * t + 4 * hi - wi.qpos + 91;
    const int dmax = __builtin_amdgcn_readfirstlane(64 * t + 63 - wi.qpos + 91);
    if (dmax <= 0) {
#pragma unroll
      for (int r = 0; r < 16; ++r) { p0[r] = fmaf(p0[r], C, wi.cfar); p1[r] = fmaf(p1[r], C, wi.cfar); }
    } else {
#pragma unroll
      for (int r = 0; r < 16; ++r) { const int i0 = dbase + (r & 3) + 8 * (r >> 2); const int a = i0 < 0 ? 0 : i0, b = i0 + 32 < 0 ? 0 : i0 + 32;
        p0[r] = fmaf(p0[r], C, tab[a]); p1[r] = fmaf(p1[r], C, tab[b]); }
    }
  }
  float pmax = p0[0];
#pragma unroll
  for (int r = 1; r < 16; ++r) pmax = fmaxf(pmax, p0[r]);
#pragma unroll
  for (int r = 0; r < 16; ++r) pmax = fmaxf(pmax, p1[r]);
  { unsigned pm2_ = __float_as_uint(pmax); asm volatile("" : "+v"(pm2_)); auto rr = __builtin_amdgcn_permlane32_swap(__float_as_uint(pmax), pm2_, false, false);
    pmax = fmaxf(__uint_as_float(rr[0]), __uint_as_float(rr[1])); }
  if (__builtin_expect(__all(pmax - m_reg <= THR2), 1)) { mn = m_reg; alpha = 1.f; }
  else { mn = fmaxf(m_reg, pmax); alpha = __builtin_amdgcn_exp2f(m_reg - mn); m_reg = mn; }
#pragma unroll
  for (int r = 0; r < 16; ++r) { p0[r] -= mn; p1[r] -= mn; }
#pragma unroll
  for (int r = 0; r < 16; ++r) p0[r] = __builtin_amdgcn_exp2f(p0[r]);
}
__device__ __forceinline__ void finishSM(f32x16& p0, f32x16& p1, float alpha, float& l_reg, bf16x8& pa0, bf16x8& pa1, bf16x8& pa2, bf16x8& pa3) {
#pragma unroll
  for (int r = 0; r < 16; ++r) p1[r] = __builtin_amdgcn_exp2f(p1[r]);
  float ps = 0;
#pragma unroll
  for (int r = 0; r < 16; ++r) ps += p0[r];
#pragma unroll
  for (int r = 0; r < 16; ++r) ps += p1[r];
  { unsigned ps2_ = __float_as_uint(ps); asm volatile("" : "+v"(ps2_)); auto rr = __builtin_amdgcn_permlane32_swap(__float_as_uint(ps), ps2_, false, false);
    ps = __uint_as_float(rr[0]) + __uint_as_float(rr[1]); }
  l_reg = l_reg * alpha + ps;
#define PK4(P, BASE, OUT) do { unsigned a0 = cvtpk(P[BASE + 0], P[BASE + 1]), a1 = cvtpk(P[BASE + 2], P[BASE + 3]);   \
    unsigned b0 = cvtpk(P[BASE + 4], P[BASE + 5]), b1 = cvtpk(P[BASE + 6], P[BASE + 7]);                              \
    auto r0 = __builtin_amdgcn_permlane32_swap(a0, b0, false, false); auto r1 = __builtin_amdgcn_permlane32_swap(a1, b1, false, false); \
    u32x4 w = {r0[0], r1[0], r0[1], r1[1]}; OUT = *reinterpret_cast<bf16x8*>(&w); } while (0)
  PK4(p0, 0, pa0); PK4(p0, 8, pa1); PK4(p1, 0, pa2); PK4(p1, 8, pa3);
#undef PK4
}
__device__ __forceinline__ void qkt(f32x16& p0, f32x16& p1, const bf16_t* Ks, const char* qf, int r32, int hi) {
  p0 = f32x16{}; p1 = f32x16{};
#pragma unroll
  for (int d0 = 0; d0 < 8; ++d0) { int cb = (d0 * 16 + hi * 8) * 2;
    bf16x8 b0 = *reinterpret_cast<const bf16x8*>((const char*)Ks + KSWZ(r32, cb));
    bf16x8 b1 = *reinterpret_cast<const bf16x8*>((const char*)Ks + KSWZ(32 + r32, cb));
    bf16x8 q = *reinterpret_cast<const bf16x8*>(qf + d0 * 1024);
    p0 = __builtin_amdgcn_mfma_f32_32x32x16_bf16(b0, q, p0, 0, 0, 0);
    p1 = __builtin_amdgcn_mfma_f32_32x32x16_bf16(b1, q, p1, 0, 0, 0); }
}
__device__ __forceinline__ int v_st(int k, int c) { const int kk = (k & ~0xC) | ((k & 4) << 1) | ((k & 8) >> 1); return ((kk >> 3) * 4 + (c >> 5)) * 512 + ((kk & 7) * 32 + (c & 31)) * 2; }
__device__ __forceinline__ int v_rd_base(int lane) { return ((lane & 3) << 3) | (((lane >> 2) & 3) << 6) | (((lane >> 4) & 1) << 5) | (((lane >> 5) & 1) << 8); }
constexpr int v_rd_off(int d0, int ks, int half) { return d0 * 512 + ks * 4096 + half * 2048; }
template <int OFF> __device__ __forceinline__ s16x4 tr_read(int vb) {
  s16x4 r; asm volatile("ds_read_b64_tr_b16 %0, %1 offset:%2" : "=&v"(r) : "v"(vb), "i"(OFF) : "memory"); return r;
}
template <int D0> __device__ __forceinline__ void pv_one(f32x16& od, int vb, bf16x8 pa0, bf16x8 pa1, bf16x8 pa2, bf16x8 pa3) {
  const s16x4 l0 = tr_read<v_rd_off(D0, 0, 0)>(vb), h0 = tr_read<v_rd_off(D0, 0, 1)>(vb), l1 = tr_read<v_rd_off(D0, 1, 0)>(vb), h1 = tr_read<v_rd_off(D0, 1, 1)>(vb);
  const s16x4 l2 = tr_read<v_rd_off(D0, 2, 0)>(vb), h2 = tr_read<v_rd_off(D0, 2, 1)>(vb), l3 = tr_read<v_rd_off(D0, 3, 0)>(vb), h3 = tr_read<v_rd_off(D0, 3, 1)>(vb);
  asm volatile("s_waitcnt lgkmcnt(0)" ::: "memory"); SBAR();
#define PK(L, H) (bf16x8){L[0], L[1], L[2], L[3], H[0], H[1], H[2], H[3]}
  od = __builtin_amdgcn_mfma_f32_32x32x16_bf16(pa0, PK(l0, h0), od, 0, 0, 0);
  od = __builtin_amdgcn_mfma_f32_32x32x16_bf16(pa1, PK(l1, h1), od, 0, 0, 0);
  od = __builtin_amdgcn_mfma_f32_32x32x16_bf16(pa2, PK(l2, h2), od, 0, 0, 0);
  od = __builtin_amdgcn_mfma_f32_32x32x16_bf16(pa3, PK(l3, h3), od, 0, 0, 0);
#undef PK
}
__device__ __forceinline__ void pv_d0(f32x16* o, int vb, bf16x8 pa0, bf16x8 pa1, bf16x8 pa2, bf16x8 pa3) {
  pv_one<0>(o[0], vb, pa0, pa1, pa2, pa3); pv_one<1>(o[1], vb, pa0, pa1, pa2, pa3); pv_one<2>(o[2], vb, pa0, pa1, pa2, pa3); pv_one<3>(o[3], vb, pa0, pa1, pa2, pa3);
}
__device__ __forceinline__ void attn_unit(const bf16_t* __restrict__ Qb, const bf16_t* __restrict__ Kh, const bf16_t* __restrict__ Vh, bf16_t* __restrict__ Ob,
                                          int NT, int ntw, int qpos0, int nvalid, char* lds) {
  int tid_ = threadIdx.x; asm volatile("" : "+v"(tid_));
  const int tid = tid_, wid = tid >> 6, lane = tid & 63, r32 = lane & 31, hi = lane >> 5;
  bf16_t* V_lds = (bf16_t*)lds; bf16_t* K_lds = (bf16_t*)(lds + 2 * SHM_V);
  float* ws = (float*)(lds + OFF_WS) + wid * 64; float* li_l = ws; float* al_l = ws + 32;
  const float* tab = (const float*)(lds + OFF_TAB);
  float m_reg = -1e30f, l_reg = 0; f32x16 o[4] = {};
  char* qf = lds + OFF_Q + wid * 8192 + (hi * 32 + r32) * 16;
  const bf16_t* Qw = Qb + (long)(wid * QBLK + r32) * LD + hi * 8;
#pragma unroll
  for (int d0 = 0; d0 < 8; ++d0) *reinterpret_cast<bf16x8*>(qf + d0 * 1024) = *reinterpret_cast<const bf16x8*>(Qw + d0 * 16);
  const int sr = tid >> 4, sc = (tid & 15) * 8, vst0 = v_st(sr, sc), vst1 = v_st(32 + sr, sc);
  const int vb0 = (int)(uintptr_t)V_lds + v_rd_base(lane);
  struct { bf16x8 vs0, vs1, ks0, ks1; } sr_[SDEPTH];
#define SLOAD(i, k0) do { sr_[i].vs0 = *reinterpret_cast<const bf16x8*>(&Vh[(long)((k0) + sr) * LD + sc]); sr_[i].vs1 = *reinterpret_cast<const bf16x8*>(&Vh[(long)((k0) + 32 + sr) * LD + sc]); \
    sr_[i].ks0 = *reinterpret_cast<const bf16x8*>(&Kh[(long)((k0) + sr) * LD + sc]); sr_[i].ks1 = *reinterpret_cast<const bf16x8*>(&Kh[(long)((k0) + 32 + sr) * LD + sc]); } while (0)
#define SWRITE(b, i) do { *(bf16x8*)((char*)V_lds + (b) * SHM_V + vst0) = sr_[i].vs0;          \
    *(bf16x8*)((char*)V_lds + (b) * SHM_V + vst1) = sr_[i].vs1; int kc = sc * 2;               \
    *(bf16x8*)((char*)K_lds + (b) * SHM_K + KSWZ(sr, kc)) = sr_[i].ks0;                       \
    *(bf16x8*)((char*)K_lds + (b) * SHM_K + KSWZ(32 + sr, kc)) = sr_[i].ks1; } while (0)
#define SWAIT() do { if constexpr (SDEPTH == 2) asm volatile("s_waitcnt vmcnt(4)" ::: "memory"); else asm volatile("s_waitcnt vmcnt(0)" ::: "memory"); } while (0)
#define RESC(a) do { if (__any((a) < 1.f)) { if (hi == 0) al_l[r32] = (a); asm volatile("s_waitcnt lgkmcnt(0)" ::: "memory"); \
    _Pragma("unroll") for (int d = 0; d < 4; ++d) _Pragma("unroll") for (int r = 0; r < 16; ++r) o[d][r] *= al_l[crow(r, hi)]; } } while (0)
  f32x16 pA0 = {}, pA1 = {}, pB0 = {}, pB1 = {}; float mnA = 0.f, mnB = 0.f, alA = 1.f, alB = 1.f; bf16x8 pa0 = {}, pa1 = {}, pa2 = {}, pa3 = {};
  const bool act = __builtin_amdgcn_readfirstlane(wid * QBLK) < nvalid;
  WaveInfo wi; wi.ntw = ntw; wi.qpos = qpos0 + wid * QBLK + r32; wi.cfar = 0.f;
  constexpr int SE = 0, SO = SDEPTH - 1;
  SLOAD(SE, 0); asm volatile("s_waitcnt vmcnt(0)" ::: "memory"); SWRITE(0, SE); __syncthreads();
  wi.cfar = tab[0];
  if (act) { qkt(pA0, pA1, K_lds, qf, r32, hi); partialSM(pA0, pA1, m_reg, mnA, alA, 0, wi, tab, hi); }
  SLOAD(SO, KVBLK); if constexpr (SDEPTH == 2) { if (2 < NT) SLOAD(SE, 2 * KVBLK); }
  SWAIT(); SWRITE(1, SO); __syncthreads();
  for (int j = 1; j + 1 < NT; j += 2) {
    SBAR(); if (act) { qkt(pB0, pB1, (bf16_t*)((char*)K_lds + SHM_K), qf, r32, hi);
    finishSM(pA0, pA1, alA, l_reg, pa0, pa1, pa2, pa3); } SBAR();
    SLOAD(SO, (j + SDEPTH) * KVBLK); SBAR();
    if (act) { pv_d0(o, vb0, pa0, pa1, pa2, pa3); partialSM(pB0, pB1, m_reg, mnB, alB, j, wi, tab, hi); }
    __syncthreads(); SWAIT(); SWRITE(0, SE);
    if (act) { RESC(alB); } __syncthreads();
    SBAR(); if (act) { qkt(pA0, pA1, K_lds, qf, r32, hi);
    finishSM(pB0, pB1, alB, l_reg, pa0, pa1, pa2, pa3); } SBAR();
    if (SDEPTH == 1 || j + 3 < NT) SLOAD(SE, (j + 1 + SDEPTH) * KVBLK); SBAR();
    if (act) { pv_d0(o, vb0 + (int)SHM_V, pa0, pa1, pa2, pa3); partialSM(pA0, pA1, m_reg, mnA, alA, j + 1, wi, tab, hi); }
    __syncthreads(); SWAIT(); SWRITE(1, SO);
    if (act) { RESC(alA); } __syncthreads();
  }
  SBAR(); if (act) { qkt(pB0, pB1, (bf16_t*)((char*)K_lds + SHM_K), qf, r32, hi);
  finishSM(pA0, pA1, alA, l_reg, pa0, pa1, pa2, pa3); } SBAR();
  if (act) { pv_d0(o, vb0, pa0, pa1, pa2, pa3); partialSM(pB0, pB1, m_reg, mnB, alB, NT - 1, wi, tab, hi); }
  __syncthreads();
  if (act) { RESC(alB);
  finishSM(pB0, pB1, alB, l_reg, pa0, pa1, pa2, pa3); SBAR();
  pv_d0(o, vb0 + (int)SHM_V, pa0, pa1, pa2, pa3); }
  if (hi == 0) li_l[r32] = l_reg; asm volatile("s_waitcnt lgkmcnt(0)" ::: "memory");
  if (act) {
    float rli[16];
#pragma unroll
    for (int r = 0; r < 16; ++r) rli[r] = __builtin_amdgcn_rcpf(li_l[crow(r, hi)]);
    bf16_t* st = (bf16_t*)(lds + OFF_Q + wid * 8192);
#pragma unroll
    for (int r = 0; r < 16; ++r) { const int orow = crow(r, hi);
#pragma unroll
      for (int d0 = 0; d0 < 4; ++d0) { const float v = o[d0][r] * rli[r]; unsigned u = __float_as_uint(v); u = (u + 0x7fffu + ((u >> 16) & 1u)) >> 16; st[orow * 128 + d0 * 32 + r32] = (bf16_t)u; } }
    asm volatile("s_waitcnt lgkmcnt(0)" ::: "memory");
    bf16_t* Ow = Ob + (long)(wid * QBLK) * LD;
#pragma unroll
    for (int i = 0; i < 4; ++i) { const int row = i * 8 + (lane >> 3), ch = lane & 7; const u32x4 v = *(const u32x4*)(st + row * 128 + ch * 8); (void)ch;
      const u32x4 v2 = *(const u32x4*)(st + row * 128 + 64 + ch * 8);
      *(u32x4*)(Ow + (long)row * LD + ch * 8) = v; *(u32x4*)(Ow + (long)row * LD + 64 + ch * 8) = v2; }
  }
  __syncthreads();
#undef SLOAD
#undef SWRITE
#undef SWAIT
#undef RESC
}
#undef KSWZ
#undef SBAR
}
namespace att2 {
using att::bf16x8; using att::s16x4; using att::f32x16; using att::u32x4; using att::bf16_t; using att::WaveInfo; using att::crow; using att::cvtpk;
constexpr int D = 128, NW = 8, QBLK = 32, KVBLK = 64, LD = 2048;
constexpr float C = att::C, THR2 = att::THR2;
constexpr int SHM_V = KVBLK * 256 * 2, SHM_K = KVBLK * D * 2;
constexpr int QW = 7168;
constexpr int OFF_K = 2 * SHM_V, OFF_WS = OFF_K + 2 * SHM_K, OFF_TAB = OFF_WS + NW * 64 * 4, NTAB = 160, OFF_Q = OFF_TAB + NTAB * 4, SHM_ATTN = OFF_Q + NW * QW;
static_assert(SHM_ATTN <= 162816, "attention LDS image fits below the workgroup's control words");
static_assert(OFF_Q % 16 == 0, "Q fragments 16-byte aligned");
#define KSWZ(row, colB) ((row) * 256 + ((colB) ^ (((row) & 7) << 4)))
#define SBAR() __builtin_amdgcn_sched_barrier(0)
#define LAS_ __attribute__((address_space(3)))
__device__ __forceinline__ void smax(f32x16& p0, f32x16& p1, float& m_reg, float& l_reg, float& alpha, int t, const WaveInfo& wi, const float* tab, int hi,
                                     bf16x8& pa0, bf16x8& pa1, bf16x8& pa2, bf16x8& pa3) {
  if (t >= wi.ntw) {
#pragma unroll
    for (int r = 0; r < 16; ++r) { p0[r] = -1e30f; p1[r] = -1e30f; }
  } else {
    const int dbase = 64 * t + 4 * hi - wi.qpos + 91;
    const int dmax = __builtin_amdgcn_readfirstlane(64 * t + 63 - wi.qpos + 91);
    if (dmax <= 0) {
#pragma unroll
      for (int r = 0; r < 16; ++r) { p0[r] = fmaf(p0[r], C, wi.cfar); p1[r] = fmaf(p1[r], C, wi.cfar); }
    } else {
#pragma unroll
      for (int r = 0; r < 16; ++r) { const int i0 = dbase + (r & 3) + 8 * (r >> 2); const int a = i0 < 0 ? 0 : i0, b = i0 + 32 < 0 ? 0 : i0 + 32;
        p0[r] = fmaf(p0[r], C, tab[a]); p1[r] = fmaf(p1[r], C, tab[b]); }
    }
  }
  float pmax = p0[0];
#pragma unroll
  for (int r = 1; r < 16; ++r) pmax = fmaxf(pmax, p0[r]);
#pragma unroll
  for (int r = 0; r < 16; ++r) pmax = fmaxf(pmax, p1[r]);
  { unsigned pm2_ = __float_as_uint(pmax); asm volatile("" : "+v"(pm2_)); auto rr = __builtin_amdgcn_permlane32_swap(__float_as_uint(pmax), pm2_, false, false);
    pmax = fmaxf(__uint_as_float(rr[0]), __uint_as_float(rr[1])); }
  float mn;
  if (__builtin_expect(__all(pmax - m_reg <= THR2), 1)) { mn = m_reg; alpha = 1.f; }
  else { mn = fmaxf(m_reg, pmax); alpha = __builtin_amdgcn_exp2f(m_reg - mn); m_reg = mn; }
#pragma unroll
  for (int r = 0; r < 16; ++r) { p0[r] = __builtin_amdgcn_exp2f(p0[r] - mn); p1[r] = __builtin_amdgcn_exp2f(p1[r] - mn); }
  float ps = 0;
#pragma unroll
  for (int r = 0; r < 16; ++r) ps += p0[r];
#pragma unroll
  for (int r = 0; r < 16; ++r) ps += p1[r];
  { unsigned ps2_ = __float_as_uint(ps); asm volatile("" : "+v"(ps2_)); auto rr = __builtin_amdgcn_permlane32_swap(__float_as_uint(ps), ps2_, false, false);
    ps = __uint_as_float(rr[0]) + __uint_as_float(rr[1]); }
  l_reg = l_reg * alpha + ps;
#define PK4(P, BASE, OUT) do { unsigned a0 = cvtpk(P[BASE + 0], P[BASE + 1]), a1 = cvtpk(P[BASE + 2], P[BASE + 3]);   \
    unsigned b0 = cvtpk(P[BASE + 4], P[BASE + 5]), b1 = cvtpk(P[BASE + 6], P[BASE + 7]);                              \
    auto r0 = __builtin_amdgcn_permlane32_swap(a0, b0, false, false); auto r1 = __builtin_amdgcn_permlane32_swap(a1, b1, false, false); \
    u32x4 w = {r0[0], r1[0], r0[1], r1[1]}; OUT = *reinterpret_cast<bf16x8*>(&w); } while (0)
  PK4(p0, 0, pa0); PK4(p0, 8, pa1); PK4(p1, 0, pa2); PK4(p1, 8, pa3);
#undef PK4
}
__device__ __forceinline__ int v_st(int k, int c) { const int kk = (k & ~0xC) | ((k & 4) << 1) | ((k & 8) >> 1); return ((kk >> 3) * 8 + (c >> 5)) * 512 + ((kk & 7) * 32 + (c & 31)) * 2; }
constexpr int v_rd_off(int d0, int ks, int half) { return d0 * 512 + ks * 8192 + half * 4096; }
template <int OFF> __device__ __forceinline__ s16x4 tr_read(int vb) {
  s16x4 r; asm volatile("ds_read_b64_tr_b16 %0, %1 offset:%2" : "=&v"(r) : "v"(vb), "i"(OFF) : "memory"); return r;
}
template <int D0> __device__ __forceinline__ void vload(s16x4 (&l)[4], s16x4 (&h)[4], int vb) {
  l[0] = tr_read<v_rd_off(D0, 0, 0)>(vb); h[0] = tr_read<v_rd_off(D0, 0, 1)>(vb); l[1] = tr_read<v_rd_off(D0, 1, 0)>(vb); h[1] = tr_read<v_rd_off(D0, 1, 1)>(vb);
  l[2] = tr_read<v_rd_off(D0, 2, 0)>(vb); h[2] = tr_read<v_rd_off(D0, 2, 1)>(vb); l[3] = tr_read<v_rd_off(D0, 3, 0)>(vb); h[3] = tr_read<v_rd_off(D0, 3, 1)>(vb);
}
__device__ __forceinline__ void vmma(f32x16& od, const s16x4 (&l)[4], const s16x4 (&h)[4], bf16x8 pa0, bf16x8 pa1, bf16x8 pa2, bf16x8 pa3) {
#define PK(L, H) (bf16x8){L[0], L[1], L[2], L[3], H[0], H[1], H[2], H[3]}
  od = __builtin_amdgcn_mfma_f32_32x32x16_bf16(pa0, PK(l[0], h[0]), od, 0, 0, 0);
  od = __builtin_amdgcn_mfma_f32_32x32x16_bf16(pa1, PK(l[1], h[1]), od, 0, 0, 0);
  od = __builtin_amdgcn_mfma_f32_32x32x16_bf16(pa2, PK(l[2], h[2]), od, 0, 0, 0);
  od = __builtin_amdgcn_mfma_f32_32x32x16_bf16(pa3, PK(l[3], h[3]), od, 0, 0, 0);
#undef PK
}
__device__ __forceinline__ void pv_all(f32x16* o, int vb, bf16x8 pa0, bf16x8 pa1, bf16x8 pa2, bf16x8 pa3) {
  s16x4 la[4], ha[4], lb[4], hb[4];
#define WAIT8() do { asm volatile("s_waitcnt lgkmcnt(8)" ::: "memory"); SBAR(); } while (0)
  vload<0>(la, ha, vb);
  vload<1>(lb, hb, vb); WAIT8(); vmma(o[0], la, ha, pa0, pa1, pa2, pa3); SBAR();
  vload<2>(la, ha, vb); WAIT8(); vmma(o[1], lb, hb, pa0, pa1, pa2, pa3); SBAR();
  vload<3>(lb, hb, vb); WAIT8(); vmma(o[2], la, ha, pa0, pa1, pa2, pa3); SBAR();
  vload<4>(la, ha, vb); WAIT8(); vmma(o[3], lb, hb, pa0, pa1, pa2, pa3); SBAR();
  vload<5>(lb, hb, vb); WAIT8(); vmma(o[4], la, ha, pa0, pa1, pa2, pa3); SBAR();
  vload<6>(la, ha, vb); WAIT8(); vmma(o[5], lb, hb, pa0, pa1, pa2, pa3); SBAR();
  vload<7>(lb, hb, vb); WAIT8(); vmma(o[6], la, ha, pa0, pa1, pa2, pa3); SBAR();
  asm volatile("s_waitcnt lgkmcnt(0)" ::: "memory"); SBAR(); vmma(o[7], lb, hb, pa0, pa1, pa2, pa3);
#undef WAIT8
}
__device__ __forceinline__ unsigned cvtpk_t(float lo, float hi) { unsigned r; asm volatile("s_nop 1\n\tv_cvt_pk_bf16_f32 %0, %1, %2" : "=v"(r) : "v"(lo), "v"(hi)); return r; }
#define PK4T(P, BASE, OUT) do { unsigned a0 = cvtpk_t(P[BASE + 0], P[BASE + 1]), a1 = cvtpk_t(P[BASE + 2], P[BASE + 3]);   \
    unsigned b0 = cvtpk_t(P[BASE + 4], P[BASE + 5]), b1 = cvtpk_t(P[BASE + 6], P[BASE + 7]);                              \
    auto r0 = __builtin_amdgcn_permlane32_swap(a0, b0, false, false); auto r1 = __builtin_amdgcn_permlane32_swap(a1, b1, false, false); \
    u32x4 w = {r0[0], r1[0], r0[1], r1[1]}; OUT = *reinterpret_cast<bf16x8*>(&w); } while (0)
__device__ __forceinline__ float max16(const f32x16& p) { return fmaxf(fmaxf(fmaxf(fmaxf(p[0], p[1]), p[2]), fmaxf(fmaxf(p[3], p[4]), p[5])), fmaxf(fmaxf(fmaxf(fmaxf(p[6], p[7]), p[8]), fmaxf(fmaxf(p[9], p[10]), p[11])), fmaxf(fmaxf(fmaxf(p[12], p[13]), p[14]), p[15]))); }
__device__ __forceinline__ void smax1(f32x16& p0, f32x16& p1, float& m_reg, float& alpha, float& cs_out, float& off_out, int t, const WaveInfo& wi, const float* tab, int hi, bf16x8& pa0, bf16x8& pa1) {
  const int dbase = 64 * t + 4 * hi - wi.qpos + 91;
  const int dmax = __builtin_amdgcn_readfirstlane(64 * t + 63 - wi.qpos + 91);
  const bool far = dmax <= 0;
  if (!far) {
#pragma unroll
    for (int r = 0; r < 16; ++r) { const int i0 = dbase + (r & 3) + 8 * (r >> 2); const int a = i0 < 0 ? 0 : i0, b = i0 + 32 < 0 ? 0 : i0 + 32;
      p0[r] = fmaf(p0[r], C, tab[a]); p1[r] = fmaf(p1[r], C, tab[b]); }
  }
  float pmax = fmaxf(max16(p0), max16(p1));
  { unsigned pm2_ = __float_as_uint(pmax); asm volatile("" : "+v"(pm2_)); auto rr = __builtin_amdgcn_permlane32_swap(__float_as_uint(pmax), pm2_, false, false);
    pmax = fmaxf(__uint_as_float(rr[0]), __uint_as_float(rr[1])); }
  if (far) pmax = fmaf(pmax, C, wi.cfar);
  float mn;
  if (__builtin_expect(__all(pmax - m_reg <= THR2), 1)) { mn = m_reg; alpha = 1.f; }
  else { mn = fmaxf(m_reg, pmax); alpha = __builtin_amdgcn_exp2f(m_reg - mn); m_reg = mn; }
  const float cs = far ? C : 1.f, off = far ? wi.cfar - mn : -mn;
  cs_out = cs; off_out = off;
#pragma unroll
  for (int r = 0; r < 16; ++r) p0[r] = __builtin_amdgcn_exp2f(fmaf(p0[r], cs, off));
  PK4T(p0, 0, pa0); PK4T(p0, 8, pa1);
}
template <int D0, int KS0> __device__ __forceinline__ void vload2(s16x4 (&l)[2], s16x4 (&h)[2], int vb) {
  l[0] = tr_read<v_rd_off(D0, KS0, 0)>(vb); h[0] = tr_read<v_rd_off(D0, KS0, 1)>(vb); l[1] = tr_read<v_rd_off(D0, KS0 + 1, 0)>(vb); h[1] = tr_read<v_rd_off(D0, KS0 + 1, 1)>(vb);
}
#define PKV(L, H) (bf16x8){L[0], L[1], L[2], L[3], H[0], H[1], H[2], H[3]}
__device__ __forceinline__ void pv_split(f32x16* o, int vb, bf16x8 pa0, bf16x8 pa1, const f32x16& p0, f32x16& p1, float cs, float off, float& l_reg, float alpha) {
  s16x4 la[2], ha[2], lb[2], hb[2]; float ps = 0.f; bf16x8 pa2, pa3;
#define WAIT4() do { asm volatile("s_waitcnt lgkmcnt(4)" ::: "memory"); SBAR(); } while (0)
#define WAIT0() do { asm volatile("s_waitcnt lgkmcnt(0)" ::: "memory"); SBAR(); } while (0)
#define STEP_A(D, L_, H_) do { o[D] = __builtin_amdgcn_mfma_f32_32x32x16_bf16(pa0, PKV(L_[0], H_[0]), o[D], 0, 0, 0); p1[2 * (D)] = __builtin_amdgcn_exp2f(fmaf(p1[2 * (D)], cs, off)); ps += p0[2 * (D)]; \
    o[D] = __builtin_amdgcn_mfma_f32_32x32x16_bf16(pa1, PKV(L_[1], H_[1]), o[D], 0, 0, 0); p1[2 * (D) + 1] = __builtin_amdgcn_exp2f(fmaf(p1[2 * (D) + 1], cs, off)); ps += p0[2 * (D) + 1]; SBAR(); } while (0)
#define STEP_B(D, L_, H_) do { o[D] = __builtin_amdgcn_mfma_f32_32x32x16_bf16(pa2, PKV(L_[0], H_[0]), o[D], 0, 0, 0); ps += p1[2 * (D)]; \
    o[D] = __builtin_amdgcn_mfma_f32_32x32x16_bf16(pa3, PKV(L_[1], H_[1]), o[D], 0, 0, 0); ps += p1[2 * (D) + 1]; SBAR(); } while (0)
  vload2<0, 0>(la, ha, vb);
  vload2<1, 0>(lb, hb, vb); WAIT4(); STEP_A(0, la, ha);
  vload2<2, 0>(la, ha, vb); WAIT4(); STEP_A(1, lb, hb);
  vload2<3, 0>(lb, hb, vb); WAIT4(); STEP_A(2, la, ha);
  vload2<4, 0>(la, ha, vb); WAIT4(); STEP_A(3, lb, hb);
  vload2<5, 0>(lb, hb, vb); WAIT4(); STEP_A(4, la, ha);
  vload2<6, 0>(la, ha, vb); WAIT4(); STEP_A(5, lb, hb);
  vload2<7, 0>(lb, hb, vb); WAIT4(); STEP_A(6, la, ha);
  vload2<0, 2>(la, ha, vb); WAIT4(); STEP_A(7, lb, hb);
  PK4T(p1, 0, pa2); PK4T(p1, 8, pa3);
  vload2<1, 2>(lb, hb, vb); WAIT4(); STEP_B(0, la, ha);
  vload2<2, 2>(la, ha, vb); WAIT4(); STEP_B(1, lb, hb);
  vload2<3, 2>(lb, hb, vb); WAIT4(); STEP_B(2, la, ha);
  vload2<4, 2>(la, ha, vb); WAIT4(); STEP_B(3, lb, hb);
  vload2<5, 2>(lb, hb, vb); WAIT4(); STEP_B(4, la, ha);
  vload2<6, 2>(la, ha, vb); WAIT4(); STEP_B(5, lb, hb);
  vload2<7, 2>(lb, hb, vb); WAIT4(); STEP_B(6, la, ha);
  WAIT0(); STEP_B(7, lb, hb);
  { unsigned ps2_ = __float_as_uint(ps); asm volatile("" : "+v"(ps2_)); auto rr = __builtin_amdgcn_permlane32_swap(__float_as_uint(ps), ps2_, false, false);
    ps = __uint_as_float(rr[0]) + __uint_as_float(rr[1]); }
  l_reg = l_reg * alpha + ps;
#undef WAIT4
#undef WAIT0
#undef STEP_A
#undef STEP_B
}
#undef PKV
#undef PK4T
__device__ __forceinline__ void qkt2(f32x16& p0, f32x16& p1, const bf16_t* Ks, const char* qf, const bf16x8 q0, int r32, int hi) {
  p0 = f32x16{}; p1 = f32x16{};
#pragma unroll
  for (int d0 = 0; d0 < 8; ++d0) { int cb = (d0 * 16 + hi * 8) * 2;
    bf16x8 b0 = *reinterpret_cast<const bf16x8*>((const char*)Ks + KSWZ(r32, cb));
    bf16x8 b1 = *reinterpret_cast<const bf16x8*>((const char*)Ks + KSWZ(32 + r32, cb));
    bf16x8 q = d0 == 0 ? q0 : *reinterpret_cast<const bf16x8*>(qf + (d0 - 1) * 1024);
    p0 = __builtin_amdgcn_mfma_f32_32x32x16_bf16(b0, q, p0, 0, 0, 0);
    p1 = __builtin_amdgcn_mfma_f32_32x32x16_bf16(b1, q, p1, 0, 0, 0); }
}
__device__ __forceinline__ void attn_unit(const bf16_t* __restrict__ Qb, const bf16_t* __restrict__ Kh, const bf16_t* __restrict__ Vh, bf16_t* __restrict__ Ob,
                                          int NT, int ntw, int qpos0, int nvalid, char* lds) {
  int tid_ = threadIdx.x; asm volatile("" : "+v"(tid_));
  const int tid = tid_, wid = tid >> 6, lane = tid & 63, r32 = lane & 31, hi = lane >> 5;
  bf16_t* V_lds = (bf16_t*)lds; bf16_t* K_lds = (bf16_t*)(lds + OFF_K);
  float* ws = (float*)(lds + OFF_WS) + wid * 64; float* li_l = ws; float* al_l = ws + 32;
  const float* tab = (const float*)(lds + OFF_TAB);
  float m_reg = -1e30f, l_reg = 0; f32x16 o[8] = {};
  char* qf = lds + OFF_Q + wid * QW + (hi * 32 + r32) * 16;
  const bf16_t* Qw = Qb + (long)(wid * QBLK + r32) * LD + hi * 8;
  const bf16x8 q0 = *reinterpret_cast<const bf16x8*>(Qw);
#pragma unroll
  for (int d0 = 1; d0 < 8; ++d0) *reinterpret_cast<bf16x8*>(qf + (d0 - 1) * 1024) = *reinterpret_cast<const bf16x8*>(Qw + d0 * 16);
  const int vb0 = (int)(uintptr_t)V_lds + att::v_rd_base(lane);
  const int wids = __builtin_amdgcn_readfirstlane(wid);
  const int kr0 = lane >> 4, kr1 = 4 + (lane >> 4);
  const bf16_t* ksrc0 = Kh + (long)(8 * wids + kr0) * LD + ((lane & 15) ^ kr0) * 8; const bf16_t* ksrc1 = Kh + (long)(8 * wids + kr1) * LD + ((lane & 15) ^ kr1) * 8;
  LAS_ unsigned char* ldsk = (LAS_ unsigned char*)K_lds + wids * 2048;
#define KDMA(k0, b) do { __builtin_amdgcn_global_load_lds((const unsigned*)(ksrc0 + (long)(k0) * LD), (LAS_ unsigned*)(ldsk + (b) * SHM_K), 16, 0, 0); \
    __builtin_amdgcn_global_load_lds((const unsigned*)(ksrc1 + (long)(k0) * LD), (LAS_ unsigned*)(ldsk + (b) * SHM_K + 1024), 16, 0, 0); } while (0)
  const int vkk = 8 * wids + ((lane & 31) >> 2), vk = (vkk & ~0xC) | ((vkk & 4) << 1) | ((vkk & 8) >> 1);
  const bf16_t* vsrc = Vh + (long)vk * LD + 32 * (lane >> 5) + 8 * (lane & 3);
  LAS_ unsigned char* ldsv = (LAS_ unsigned char*)V_lds + wids * 4096;
#define VDMA(k0, b) do { _Pragma("unroll") for (int i_ = 0; i_ < 4; ++i_) \
    __builtin_amdgcn_global_load_lds((const unsigned*)(vsrc + (long)(k0) * LD + 64 * i_), (LAS_ unsigned*)(ldsv + (b) * SHM_V + i_ * 1024), 16, 0, 0); } while (0)
  const bool act = __builtin_amdgcn_readfirstlane(wid * QBLK) < nvalid;
  WaveInfo wi; wi.ntw = ntw; wi.qpos = qpos0 + wid * QBLK + r32; wi.cfar = 0.f;
  VDMA(0, 0); KDMA(0, 0); asm volatile("s_waitcnt vmcnt(0)" ::: "memory");
  __syncthreads();
  wi.cfar = tab[0];
  for (int j = 0; j < NT; ++j) {
    f32x16 p0, p1; bf16x8 pa0, pa1; float alpha;
    if (j + 1 < NT) { VDMA((j + 1) * KVBLK, (j + 1) & 1); KDMA((j + 1) * KVBLK, (j + 1) & 1); }
    SBAR();
    const bool vis = act && j < ntw;
    if (vis) {
      qkt2(p0, p1, K_lds + (j & 1) * (SHM_K / 2), qf, q0, r32, hi);
      float cs_, off_; smax1(p0, p1, m_reg, alpha, cs_, off_, j, wi, tab, hi, pa0, pa1);
      if (__any(alpha < 1.f)) { if (hi == 0) al_l[r32] = alpha; asm volatile("s_waitcnt lgkmcnt(0)" ::: "memory");
#pragma unroll
        for (int r = 0; r < 16; ++r) { const float a = al_l[crow(r, hi)];
#pragma unroll
          for (int d = 0; d < 8; ++d) o[d][r] *= a; } }
      const int vb = vb0 + (j & 1) * SHM_V;
      pv_split(o, vb, pa0, pa1, p0, p1, cs_, off_, l_reg, alpha);
    }
    asm volatile("s_waitcnt vmcnt(0)" ::: "memory");
    __syncthreads();
  }
  if (hi == 0) li_l[r32] = l_reg; asm volatile("s_waitcnt lgkmcnt(0)" ::: "memory");
  if (act) {
    float rli[16];
#pragma unroll
    for (int r = 0; r < 16; ++r) rli[r] = __builtin_amdgcn_rcpf(li_l[crow(r, hi)]);
    bf16_t* st = (bf16_t*)(lds + wid * 8192);
    bf16_t* Ow = Ob + (long)(wid * QBLK) * LD;
#pragma unroll
    for (int hv = 0; hv < 2; ++hv) {
#pragma unroll
      for (int r = 0; r < 16; ++r) { const int orow = crow(r, hi);
#pragma unroll
        for (int d0 = 0; d0 < 4; ++d0) { const float v = o[hv * 4 + d0][r] * rli[r]; unsigned u = __float_as_uint(v); u = (u + 0x7fffu + ((u >> 16) & 1u)) >> 16; st[orow * 128 + d0 * 32 + r32] = (bf16_t)u; } }
      asm volatile("s_waitcnt lgkmcnt(0)" ::: "memory");
#pragma unroll
      for (int i = 0; i < 4; ++i) { const int row = i * 8 + (lane >> 3), ch = lane & 7; const u32x4 v = *(const u32x4*)(st + row * 128 + ch * 8), v2 = *(const u32x4*)(st + row * 128 + 64 + ch * 8);
        *(u32x4*)(Ow + (long)row * LD + hv * 128 + ch * 8) = v; *(u32x4*)(Ow + (long)row * LD + hv * 128 + 64 + ch * 8) = v2; }
      asm volatile("s_waitcnt lgkmcnt(0)" ::: "memory");
    }
  }
  __syncthreads();
#undef KDMA
#undef VDMA
}
#undef KSWZ
#undef SBAR
#undef LAS_
}
#define XB_TMO      128
#define XB_XCNT(j)  (256  + 64 * (j))
#define XB_XSUB(j)  (1280 + 64 * (j))
#define XB_XGEN(j)  (2304 + 64 * (j))
#define XB_TOP      3328
#define XB_TOPGEN   3392
#define XCD_BAR_WORDS 3456
#define XB_SPIN_CAP (1u << 22)

__device__ __forceinline__ unsigned xb_ld(unsigned* p)              { return __hip_atomic_load(p, __ATOMIC_RELAXED, __HIP_MEMORY_SCOPE_AGENT); }
__device__ __forceinline__ unsigned xb_add(unsigned* p, unsigned v) { return __hip_atomic_fetch_add(p, v, __ATOMIC_RELAXED, __HIP_MEMORY_SCOPE_AGENT); }
__device__ __forceinline__ unsigned xb_xcc_id() { return (unsigned)__builtin_amdgcn_s_getreg((3 << 11) | 20) & 0xFu; }
#define XB_SPIN(cond, bar) do { unsigned _sp = 0; while (cond) { __builtin_amdgcn_s_sleep(1); \
    if ((++_sp & 255u) == 0u) { if (xb_ld(&(bar)[XB_TMO])) break; if (_sp > XB_SPIN_CAP) { atomicAdd(&(bar)[XB_TMO], 1u); break; } } } } while (0)

struct XcdBarrier {
    unsigned* bar; unsigned x;
    volatile LAS unsigned* st;
};

__device__ __forceinline__ XcdBarrier xcd_barrier_post(unsigned* bar, volatile LAS unsigned* st) {
    XcdBarrier b; b.bar = bar; b.x = xb_xcc_id(); b.st = st;
    if (threadIdx.x == 0) (void)xb_add(&bar[XB_XCNT(b.x)], 1u);
    return b;
}
__device__ __forceinline__ void xcd_barrier_complete(unsigned* bar, unsigned x, unsigned& nloc, unsigned& nx) {
    const unsigned G = gridDim.x * gridDim.y * gridDim.z;
    unsigned sum, cnt, mine, sp = 0u;
    for (;;) {
        sum = 0u; cnt = 0u; mine = 0u;
#pragma unroll
        for (unsigned j = 0; j < 16; ++j) { const unsigned c = xb_ld(&bar[XB_XCNT(j)]); sum += c; cnt += (c > 0u) ? 1u : 0u; mine = (j == x) ? c : mine; }
        if (sum == G) break;
        __builtin_amdgcn_s_sleep(1);
        if ((++sp & 255u) == 0u) { if (xb_ld(&bar[XB_TMO])) break; if (sp > XB_SPIN_CAP) { atomicAdd(&bar[XB_TMO], 1u); break; } }
    }
    nloc = mine > 0u ? mine : 1u; nx = cnt > 0u ? cnt : 1u;
}

__device__ __forceinline__ void xcd_barrier(const XcdBarrier& b) {
    asm volatile("s_waitcnt vmcnt(0)" ::: "memory");
    __syncthreads();
    if (threadIdx.x == 0) {
        unsigned* bar = b.bar;
        __builtin_amdgcn_s_waitcnt(0);
        unsigned nloc = b.st[0], nx = b.st[1];
        if (nloc == 0u) { xcd_barrier_complete(bar, b.x, nloc, nx); b.st[0] = nloc; b.st[1] = nx; }
        const unsigned old = xb_add(&bar[XB_XSUB(b.x)], 1u);
        const unsigned gen = old / nloc;
        if (old + 1u == (gen + 1u) * nloc) {
            __builtin_amdgcn_fence(__ATOMIC_RELEASE, "agent");
            asm volatile("s_waitcnt vmcnt(0)" ::: "memory");
            const unsigned og = xb_add(&bar[XB_TOP], 1u);
            const unsigned tg = og / nx;
            if (og + 1u == (tg + 1u) * nx) xb_add(&bar[XB_TOPGEN], 1u);
            else XB_SPIN(xb_ld(&bar[XB_TOPGEN]) == tg, bar);
            __builtin_amdgcn_fence(__ATOMIC_ACQUIRE, "agent");
            xb_add(&bar[XB_XGEN(b.x)], 1u);
            asm volatile("s_waitcnt vmcnt(0)" ::: "memory");
        } else {
            XB_SPIN(xb_ld(&bar[XB_XGEN(b.x)]) == gen, bar);
            __builtin_amdgcn_fence(__ATOMIC_ACQUIRE, "agent");
            asm volatile("s_waitcnt vmcnt(0)" ::: "memory");
        }
    }
    __syncthreads();
}
__device__ __forceinline__ void norm_row(const float* xrow, const float* gain, int lane, f32x4 (&v)[8]) {
    const GAS f32x4* xr = (const GAS f32x4*)xrow + lane; float s = 0.f;
#pragma unroll
    for (int j = 0; j < 8; ++j) { v[j] = xr[64 * j]; s += (v[j].x * v[j].x + v[j].y * v[j].y) + (v[j].z * v[j].z + v[j].w * v[j].w); }
    const float rstd = 1.f / sqrtf(wave_sum(s) * (1.f / DM) + EPS);
    const GAS f32x4* gr = (const GAS f32x4*)gain + lane;
#pragma unroll
    for (int j = 0; j < 8; ++j) { const f32x4 g = gr[64 * j]; v[j] = v[j] * rstd * g; }
}
__device__ __forceinline__ void store_row_bf16(bf16* orow, int lane, const f32x4 (&v)[8]) {
    GAS v2u* o8 = (GAS v2u*)orow + lane;
#pragma unroll
    for (int j = 0; j < 8; ++j) { v2u w; w.x = pk2(v[j].x, v[j].y); w.y = pk2(v[j].z, v[j].w); o8[64 * j] = w; }
}
__device__ __forceinline__ void transpose_item(const float* W, int N, bf16* WT, int ldo, int koff, int orow0, int k0, int n0, LAS float* scr, int lane, const float* gk) {
#pragma unroll 8
    for (int i = 0; i < 32; ++i) { const int kk = 2 * i + (lane >> 5); scr[kk * 33 + (lane & 31)] = __builtin_nontemporal_load(&W[(size_t)(k0 + kk) * N + n0 + (lane & 31)]); }
    LDS_WAIT(); asm volatile("" ::: "memory");
    const int c = lane & 7;
    f32x4 g0 = {1.f, 1.f, 1.f, 1.f}, g1 = g0; if (gk) { g0 = *(const GAS f32x4*)(gk + k0 + 8 * c); g1 = *(const GAS f32x4*)(gk + k0 + 8 * c + 4); }
#pragma unroll
    for (int j = 0; j < 4; ++j) { const int n = (lane >> 3) + 8 * j; const LAS float* s = scr + (8 * c) * 33 + n;
        v4u o; o.x = pk2(s[0 * 33] * g0.x, s[1 * 33] * g0.y); o.y = pk2(s[2 * 33] * g0.z, s[3 * 33] * g0.w); o.z = pk2(s[4 * 33] * g1.x, s[5 * 33] * g1.y); o.w = pk2(s[6 * 33] * g1.z, s[7 * 33] * g1.w);
        __builtin_nontemporal_store(o, (GAS v4u*)(WT + (size_t)(orow0 + n) * ldo + koff + k0 + 8 * c)); }
    LDS_WAIT(); asm volatile("" ::: "memory");
}
__device__ __forceinline__ int rel_bucket(int rel) {
    const int n = rel < 0 ? -rel : rel; int b;
    if (n < 8) b = n; else if (n < 12) b = 8; else if (n < 16) b = 9; else if (n < 23) b = 10; else if (n < 32) b = 11; else if (n < 46) b = 12; else if (n < 64) b = 13; else if (n < 91) b = 14; else b = 15;
    return b + (rel > 0 ? 16 : 0);
}

#ifndef SKIP_P0
#define SKIP_P0 0
#endif
#ifndef SKIP_N1
#define SKIP_N1 0
#endif
#ifndef SKIP_GIN
#define SKIP_GIN 0
#endif
#ifndef SKIP_ATT
#define SKIP_ATT 0
#endif
#ifndef SKIP_COMB
#define SKIP_COMB 0
#endif
#ifndef SKIP_GBR
#define SKIP_GBR 0
#endif
#ifndef SKIP_GOUT
#define SKIP_GOUT 0
#endif
#ifndef SKIP_N2
#define SKIP_N2 0
#endif
#ifndef SKIP_GUP
#define SKIP_GUP 0
#endif
#ifndef SKIP_GDN
#define SKIP_GDN 0
#endif
#ifndef SKIP_N3
#define SKIP_N3 0
#endif
#ifndef SKIP_GPLE
#define SKIP_GPLE 0
#endif
constexpr int KV_CHL = 8 * 1024 * 2048 / 8;
#ifndef KV_F1_NUM
#define KV_F1_NUM 6
#define KV_F2_NUM 20
#endif
constexpr int KV_F1 = KV_F1_NUM * (KV_CHL / 16), KV_F2 = KV_F2_NUM * (KV_CHL / 16);
template <int UNR> __device__ __forceinline__ void kv_convert1(const float* src, size_t wsoff, unsigned char* ws, int L, int jb, int je, int wk, int nwk, int lane) {
    const GAS f32x4* s4 = (const GAS f32x4*)(src + (size_t)L * KV_CHL * 8); bf16* dst = (bf16*)(ws + wsoff) + (size_t)L * DB * KROWS * DM;
    for (int j0 = jb + wk * (64 * UNR); j0 < je; j0 += nwk * (64 * UNR)) {
        f32x4 a[UNR], b[UNR];
#pragma unroll
        for (int u = 0; u < UNR; ++u) { const int j = j0 + u * 64 + lane; a[u] = __builtin_nontemporal_load(s4 + 2 * (size_t)j); b[u] = __builtin_nontemporal_load(s4 + 2 * (size_t)j + 1); }
#pragma unroll
        for (int u = 0; u < UNR; ++u) { const int j = j0 + u * 64 + lane; const int row = j >> 8, col = (j & 255) * 8;
            v4u o; o.x = pk2(a[u].x, a[u].y); o.y = pk2(a[u].z, a[u].w); o.z = pk2(b[u].x, b[u].y); o.w = pk2(b[u].z, b[u].w);
            __builtin_nontemporal_store(o, (GAS v4u*)(dst + ((size_t)(row >> 10) * KROWS + (row & 1023)) * DM + col)); }
    }
}
__device__ __forceinline__ void kv_convert1_dma(const float* src, size_t wsoff, unsigned char* ws, int L, int jb, int je, int wk, int nwk, int lane, LAS unsigned char* myl) {
    const float* s0 = src + (size_t)L * KV_CHL * 8; bf16* dst = (bf16*)(ws + wsoff) + (size_t)L * DB * KROWS * DM;
    for (int j0 = jb + wk * 512; j0 < je; j0 += nwk * 512) {
        const float* g = s0 + (size_t)j0 * 8 + lane * 4;
#pragma unroll
        for (int i = 0; i < 16; ++i) __builtin_amdgcn_global_load_lds((const unsigned*)(g + i * 256), (LAS unsigned*)(myl + i * 1024), 16, 0, 0);
        asm volatile("s_waitcnt vmcnt(0)" ::: "memory");
#pragma unroll
        for (int u = 0; u < 8; ++u) { const int c = u * 64 + lane, j = j0 + c; const int row = j >> 8, col = (j & 255) * 8;
            const f32x4 a = *(const LAS f32x4*)(myl + c * 32), b = *(const LAS f32x4*)(myl + c * 32 + 16);
            v4u o; o.x = pk2(a.x, a.y); o.y = pk2(a.z, a.w); o.z = pk2(b.x, b.y); o.w = pk2(b.z, b.w);
            __builtin_nontemporal_store(o, (GAS v4u*)(dst + ((size_t)(row >> 10) * KROWS + (row & 1023)) * DM + col)); }
        asm volatile("s_waitcnt lgkmcnt(0)" ::: "memory");
    }
}
template <int JB, int JE> __device__ __forceinline__ void kv_convert_dma(const float* kin, const float* vin, unsigned char* ws, int L, int wk, int nwk, int lane, LAS unsigned char* myl) {
    constexpr int kb = JB < KV_CHL ? JB : KV_CHL, ke = JE < KV_CHL ? JE : KV_CHL, vb = (JB > KV_CHL ? JB : KV_CHL) - KV_CHL, ve = (JE > KV_CHL ? JE : KV_CHL) - KV_CHL;
    if constexpr (kb < ke) kv_convert1_dma(kin, WS_KALL, ws, L, kb, ke, wk, nwk, lane, myl);
    if constexpr (vb < ve) kv_convert1_dma(vin, WS_VALL, ws, L, vb, ve, wk, nwk, lane, myl);
}
template <int JB, int JE, int UNR> __device__ __forceinline__ void kv_convert(const float* kin, const float* vin, unsigned char* ws, int L, int wk, int nwk, int lane) {
    constexpr int kb = JB < KV_CHL ? JB : KV_CHL, ke = JE < KV_CHL ? JE : KV_CHL, vb = (JB > KV_CHL ? JB : KV_CHL) - KV_CHL, ve = (JE > KV_CHL ? JE : KV_CHL) - KV_CHL;
    if constexpr (kb < ke) kv_convert1<UNR>(kin, WS_KALL, ws, L, kb, ke, wk, nwk, lane);
    if constexpr (vb < ve) kv_convert1<UNR>(vin, WS_VALL, ws, L, vb, ve, wk, nwk, lane);
}
struct Args { const float* in[27]; float* out; unsigned char* ws; int ph_lo, ph_hi; };
#define CAS __attribute__((address_space(4)))
constexpr int NPH_LAYER = 8, PH_FINAL = 1 + DEPTH * NPH_LAYER, NPHASES = PH_FINAL + 1;
constexpr int TR_ITEMS_LAYER = 37632;

#define X ((bf16*)(ws + WS_X))
#define AH ((bf16*)(ws + WS_AH))
#define APLE ((bf16*)(ws + WS_APLE + (size_t)L * APLE_BYTES))
#define SS(i) ((bf16*)(ws + WS_SSP) + (size_t)(i) * M * 8)
#define LQ ((LAS float*)(ldsl + LDS_SSQ))
#define ZC ((bf16*)(ws + WS_ZC))
#define QB ((bf16*)(ws + WS_QB))
#define KB ((bf16*)(ws + WS_KB))
#define VB ((bf16*)(ws + WS_VB))
#define GG ((bf16*)(ws + WS_GG))
#define OP ((bf16*)(ws + WS_OP))
#define ABR ((bf16*)(ws + WS_ABR))
#define MB ((bf16*)(ws + WS_MB))
#define ACT ((bf16*)(ws + WS_ACT))
#define PP ((bf16*)(ws + WS_PP))
#define WL ((bf16*)(ws + WS_W + (size_t)L * LW_BYTES))
#define KALL ((bf16*)(ws + WS_KALL) + (size_t)L * DB * KROWS * DM)
#define VALL ((bf16*)(ws + WS_VALL) + (size_t)L * DB * KROWS * DM)
__global__ void __launch_bounds__(NWAVES * 64, 2) trunk_fwd(Args args) {
    extern __shared__ __attribute__((aligned(16))) unsigned char lds[];
    LAS unsigned char* ldsl = (LAS unsigned char*)lds;
    volatile LAS unsigned* MISC = (volatile LAS unsigned*)(ldsl + MISC_OFF);
    const int tid0 = threadIdx.x, wave = __builtin_amdgcn_readfirstlane(tid0 >> 6);
#define PHASE_TID() int tid = threadIdx.x; asm volatile("" : "+v"(tid)); const int lane = tid & 63; (void)lane;     \
    const CAS Args* ka = (const CAS Args*)__builtin_amdgcn_kernarg_segment_ptr(); asm volatile("" : "+s"(ka)); unsigned char* ws = ka->ws; float* out = ka->out; (void)out; (void)ws; int gw = gw0; asm volatile("" : "+s"(gw)); (void)gw; int Gq = G, bxq = bx, vcuq = vcu; asm volatile("" : "+s"(Gq), "+s"(bxq), "+s"(vcuq)); (void)Gq; (void)bxq; (void)vcuq
#define KV_TAIL(NUNITS, JB, JE, LAYER) do { int t2_ = threadIdx.x; asm volatile("" : "+v"(t2_)); const int lane2_ = t2_ & 63, wave2_ = __builtin_amdgcn_readfirstlane(t2_ >> 6); \
        const CAS Args* kb_ = (const CAS Args*)__builtin_amdgcn_kernarg_segment_ptr(); asm volatile("" : "+s"(kb_)); int G2_ = gridDim.x, b2_ = blockIdx.x; asm volatile("" : "+s"(G2_), "+s"(b2_)); \
        const int rem_ = (NUNITS) % G2_; \
        LAS unsigned char* myl_ = ldsl + RING_OFF + wave2_ * 16384; \
        if (rem_ == 0) kv_convert_dma<(JB), (JE)>(kb_->in[4], kb_->in[5], kb_->ws, (LAYER), b2_ * NWAVES + wave2_, G2_ * NWAVES, lane2_, myl_); \
        else if (b2_ >= rem_) kv_convert_dma<(JB), (JE)>(kb_->in[4], kb_->in[5], kb_->ws, (LAYER), (b2_ - rem_) * NWAVES + wave2_, (G2_ - rem_) * NWAVES, lane2_, myl_); } while (0)
    const int G = gridDim.x; const int bx = blockIdx.x; const int vcu = (G % 8 == 0) ? (bx % 8) * (G / 8) + bx / 8 : bx;
    unsigned* ctl = (unsigned*)(args.ws + WS_CTL);
    for (int u = tid0; u < (LDS_BYTES - LDSCTL_OFF) / 4; u += NWAVES * 64) ((LAS unsigned*)(ldsl + LDSCTL_OFF))[u] = 0u;
    __syncthreads();
    XcdBarrier bar = xcd_barrier_post(ctl + CW_BAR, MISC + 8);
    const int lo = args.ph_lo, hi = args.ph_hi;
#define IN(k) (lo <= (k) && (k) < hi)
#define SEAM(k) do { if (IN((k) + 1)) xcd_barrier(bar); } while (0)
    const int gw0 = vcu * NWAVES + wave, NGW = G * NWAVES;

    if (IN(0) && !SKIP_P0) {
            PHASE_TID();
        LAS float* scr = (LAS float*)(ldsl + RING_OFF + wave * 16384);
        for (int it = gw; it < DEPTH * TR_ITEMS_LAYER; it += NGW) {
            const int L = it / TR_ITEMS_LAYER; int r = it % TR_ITEMS_LAYER;
            const float* W; int K, N, ldo, koff, map = 0; bf16* dst; const float* gk = nullptr;
            if (r < 13312) { W = ka->in[9]; K = DM; N = DIN; dst = WL + LW_IN / 2; ldo = DM; koff = 0; gk = ka->in[8] + (size_t)L * DM; }
            else if ((r -= 13312) < 1024) { W = ka->in[16]; K = DCONV; N = DM; dst = WL + LW_BR / 2; ldo = KBR; koff = 0; }
            else if ((r -= 1024) < 2048) { W = ka->in[17]; K = DATTN; N = DM; dst = WL + LW_BR / 2; ldo = KBR; koff = DCONV; }
            else if ((r -= 2048) < 2048) { W = ka->in[18]; K = DM; N = DM; dst = WL + LW_OUT / 2; ldo = DM; koff = 0; }
            else if ((r -= 2048) < 5632) { W = ka->in[20]; K = DM; N = DFF; dst = WL + LW_13 / 2; ldo = DM; koff = 0; map = 1; gk = ka->in[19] + (size_t)L * DM; }
            else if ((r -= 5632) < 5632) { W = ka->in[21]; K = DM; N = DFF; dst = WL + LW_13 / 2; ldo = DM; koff = 0; map = 2; gk = ka->in[19] + (size_t)L * DM; }
            else if ((r -= 5632) < 5632) { W = ka->in[22]; K = DFF; N = DM; dst = WL + LW_2 / 2; ldo = DFF; koff = 0; }
            else if ((r -= 5632) < 256) { W = ka->in[24]; K = DPLE; N = DM; dst = WL + LW_PLE / 2; ldo = KPLE; koff = 0; }
            else { r -= 256; W = ka->in[25]; K = DM; N = DM; dst = WL + LW_PLE / 2; ldo = KPLE; koff = DPLE; }
            W += (size_t)L * K * N;
            const int nblk = N / 32, kb = r / nblk, nb = r % nblk, n0 = 32 * nb;
            const int orow0 = map == 0 ? n0 : ((n0 >> 7) * 256 + (n0 & 127) + (map == 2 ? 128 : 0));
            transpose_item(W, N, dst, ldo, koff, orow0, 64 * kb, n0, scr, lane, gk);
        }
        kv_convert<KV_F1, 2 * KV_CHL, 4>(ka->in[4], ka->in[5], ws, 0, gw, NGW, lane);
        for (int Lk = 1; Lk < DEPTH; ++Lk) kv_convert<KV_F2, 2 * KV_CHL, 4>(ka->in[4], ka->in[5], ws, Lk, gw, NGW, lane);
        {
            for (int m = gw; m < M; m += NGW) {
                const float* xrow = m < MP ? ka->in[0] + (size_t)m * DM : ka->in[1] + (size_t)(m - MP) * DM;
                const GAS f32x4* xr = (const GAS f32x4*)xrow + lane; GAS v2u* xo = (GAS v2u*)(X + (size_t)m * DM) + lane; f32x4 v[8]; float s = 0.f;
#pragma unroll
                for (int j = 0; j < 8; ++j) { v[j] = xr[64 * j]; v2u w_; w_.x = pk2(v[j].x, v[j].y); w_.y = pk2(v[j].z, v[j].w); xo[64 * j] = w_; s += (v[j].x * v[j].x + v[j].y * v[j].y) + (v[j].z * v[j].z + v[j].w * v[j].w); }
                s = wave_sum(s); if (lane < 8) SS(0)[(size_t)m * 8 + lane] = lane == 0 ? (bf16)f2bf(s) : (bf16)0;
            }
        }
        {
            constexpr int CHL = M * DPLE / 8;
            for (int c = vcu * (NWAVES * 64) + tid; c < DEPTH * CHL; c += G * NWAVES * 64) {
                const int L = c / CHL, cc = c % CHL, row = cc >> 5, col = (cc & 31) * 8;
                const float* src = row < MP ? ka->in[2] + ((size_t)L * MP + row) * DPLE + col : ka->in[3] + ((size_t)L * MS + (row - MP)) * DPLE + col;
                const f32x4 a = ((const GAS f32x4*)src)[0], b = ((const GAS f32x4*)src)[1]; v4u o; o.x = pk2(a.x, a.y); o.y = pk2(a.z, a.w); o.z = pk2(b.x, b.y); o.w = pk2(b.z, b.w);
                *(GAS v4u*)(APLE + (size_t)row * KPLE + col) = o;
            }
        }
        SEAM(0);
    }

    for (int L = 0; L < DEPTH; ++L) {
        const int pb = 1 + L * NPH_LAYER;
        const float lam_init = 0.8f - 0.6f * expf(-0.3f * (float)L);

        if (IN(pb + 0) && !SKIP_GIN) {
            PHASE_TID();
            pg8::Gemm g{X, WL + LW_IN / 2, M, DIN, DM};     pg8::StaticOrder S; S.init(M, DIN, Gq, bxq);
            pg8::EpiIn E{ws, out, L, SS(3 * L + 0)};
            pg8::gemm_phase<pg8::EpiIn, pg8::StaticOrder, true, true>(ldsl + RING_OFF, g, S, E);
            { KV_TAIL((M / 256) * (DIN / 256), 0, KV_F1, L); }
            SEAM(pb + 0);
        }
        if (IN(pb + 1) && !SKIP_ATT) {
            PHASE_TID();
            float* tab = (float*)(lds + att2::OFF_TAB);
            for (int it = vcuq; it < 256; it += Gq) {
                const int bh = it >> 3, k = it & 7, b = bh >> 3, h = bh & 7, j = k & 1, role = k >> 1;
                if (tid < att2::NTAB) { const int rel = tid - 91; tab[tid] = (tid < 155) ? ka->in[7][rel_bucket(rel) * NH + h] * att::LOG2E : 0.f; }
                const int nitem = role < 2 ? 2 : 3;
                for (int qi = 0; qi < nitem; ++qi) {
                    const int code = role == 0 ? (qi == 0 ? 7 : 8) : role == 1 ? (qi == 0 ? 6 : 3) : role == 2 ? (qi == 0 ? 5 : qi == 1 ? 2 : 0) : (qi == 0 ? 4 : qi == 1 ? 1 : 9);
                    const bool prompt = code < 8; const int qb = code, sb = 2 * b + (code - 8);
                    const size_t rq = prompt ? (size_t)b * SEQ + 256 * qb : (size_t)MP + sb * DSEQ, rk = prompt ? (size_t)b * SEQ : (size_t)sb * KROWS;
                    const bf16* Kp = prompt ? KB : KALL; const bf16* Vp = prompt ? VB : VALL;
                    att2::attn_unit(QB + rq * DM + h * 256 + j * 128, Kp + rk * DM + h * 256 + j * 128, Vp + rk * DM + h * 256,
                                    OP + (size_t)j * M * DM + rq * DM + h * 256, prompt ? 4 * (qb + 1) : 18, prompt ? 4 * qb + (wave >> 1) + 1 : 17,
                                    prompt ? 256 * qb : PAST, prompt ? 256 : DSEQ, (char*)lds);
                }
            }
            SEAM(pb + 1);
        }
        if (IN(pb + 2) && !SKIP_COMB) {
            PHASE_TID();
            float lam;
            {   const float* q1 = ka->in[11] + L * HD; const float* k1 = ka->in[12] + L * HD; const float* q2 = ka->in[13] + L * HD; const float* k2 = ka->in[14] + L * HD;
                const float s1 = wave_sum(q1[lane] * k1[lane] + q1[lane + 64] * k1[lane + 64]), s2 = wave_sum(q2[lane] * k2[lane] + q2[lane + 64] * k2[lane + 64]);
                lam = expf(s1) - expf(s2) + lam_init; }
            const GAS f32x4* gsp = (const GAS f32x4*)(ka->in[15] + (size_t)L * 256 + (lane & 31) * 8); const f32x4 gs0 = gsp[0], gs1 = gsp[1];
            const float osc = 1.f - lam_init;
            for (int m = gw; m < M; m += NGW) {
                const bf16* o1 = OP + (size_t)m * DM; const bf16* o2 = OP + (size_t)M * DM + (size_t)m * DM; bf16* orow = ABR + (size_t)m * KBR + DCONV;
                v4u aw[4], cw2[4];
#pragma unroll
                for (int i = 0; i < 4; ++i) { aw[i] = ((const GAS v4u*)(o1 + i * 512))[lane]; cw2[i] = ((const GAS v4u*)(o2 + i * 512))[lane]; }
#pragma unroll
                for (int i = 0; i < 4; ++i) {
                    const f32x4 d0 = (f32x4){bf_lo(aw[i].x), bf_hi(aw[i].x), bf_lo(aw[i].y), bf_hi(aw[i].y)} - lam * (f32x4){bf_lo(cw2[i].x), bf_hi(cw2[i].x), bf_lo(cw2[i].y), bf_hi(cw2[i].y)};
                    const f32x4 d1 = (f32x4){bf_lo(aw[i].z), bf_hi(aw[i].z), bf_lo(aw[i].w), bf_hi(aw[i].w)} - lam * (f32x4){bf_lo(cw2[i].z), bf_hi(cw2[i].z), bf_lo(cw2[i].w), bf_hi(cw2[i].w)};
                    const float ss = half_sum(((d0.x * d0.x + d0.y * d0.y) + (d0.z * d0.z + d0.w * d0.w)) + ((d1.x * d1.x + d1.y * d1.y) + (d1.z * d1.z + d1.w * d1.w)));
                    const float r = osc / sqrtf(ss * (1.f / 256.f) + EPS);
                    v4u w; w.x = pk2(d0.x * r * gs0.x, d0.y * r * gs0.y); w.y = pk2(d0.z * r * gs0.z, d0.w * r * gs0.w); w.z = pk2(d1.x * r * gs1.x, d1.y * r * gs1.y); w.w = pk2(d1.z * r * gs1.z, d1.w * r * gs1.w);
                    ((GAS v4u*)(orow + i * 512))[lane] = w;
                }
            }
            const float* cw = ka->in[10] + (size_t)L * 3 * DCONV;
            for (int it = gw; it < M / 4; it += NGW) {
                const int r0 = it * 4; const bool prompt = r0 < MP;
                const int tpos = prompt ? (r0 & (SEQ - 1)) : ((r0 - MP) & (DSEQ - 1)); const int slen = prompt ? SEQ : DSEQ; const int sb = prompt ? (r0 >> 11) : ((r0 - MP) >> 6);
#pragma unroll
                for (int hf = 0; hf < 2; ++hf) {
                    const int c0 = hf * 512 + lane * 8;
                    float w0[8], w1[8], w2[8], um2[8], um1[8];
                    v4u cc[6], xx[6], bb[4];
                    const int pfirst = tpos >= 2 ? 0 : 2;
#pragma unroll
                    for (int p = 0; p < 6; ++p) { if (p >= pfirst) { const bf16* zr = ZC + (size_t)(r0 - 2 + p) * 3072; cc[p] = *(const GAS v4u*)(zr + 1024 + c0); xx[p] = *(const GAS v4u*)(zr + 2048 + c0); if (p >= 2) bb[p - 2] = *(const GAS v4u*)(zr + c0); }
                        else { cc[p] = (v4u){0u, 0u, 0u, 0u}; xx[p] = (v4u){0u, 0u, 0u, 0u}; } }
                    {   const GAS f32x4* c4 = (const GAS f32x4*)(cw + c0);
                        const f32x4 a0 = c4[0], a1 = c4[1], b0 = c4[DCONV / 4], b1 = c4[DCONV / 4 + 1], d0 = c4[2 * DCONV / 4], d1 = c4[2 * DCONV / 4 + 1];
#pragma unroll
                        for (int i = 0; i < 4; ++i) { w0[i] = a0[i]; w0[4 + i] = a1[i]; w1[i] = b0[i]; w1[4 + i] = b1[i]; w2[i] = d0[i]; w2[4 + i] = d1[i]; } }
#define CONV_U(U, C, Xx) do { U[0] = bf_lo(C.x) * bf_lo(Xx.x); U[1] = bf_hi(C.x) * bf_hi(Xx.x); U[2] = bf_lo(C.y) * bf_lo(Xx.y); U[3] = bf_hi(C.y) * bf_hi(Xx.y); \
                        U[4] = bf_lo(C.z) * bf_lo(Xx.z); U[5] = bf_hi(C.z) * bf_hi(Xx.z); U[6] = bf_lo(C.w) * bf_lo(Xx.w); U[7] = bf_hi(C.w) * bf_hi(Xx.w); } while (0)
                    if (tpos >= 2) { CONV_U(um2, cc[0], xx[0]); CONV_U(um1, cc[1], xx[1]); }
                    else if (prompt) {
#pragma unroll
                        for (int i = 0; i < 8; ++i) { um2[i] = 0.f; um1[i] = 0.f; }
                    } else {
                        const GAS f32x4* cp = (const GAS f32x4*)(ka->in[6] + ((size_t)(L * DB + sb) * 2) * DCONV + c0);
                        const f32x4 p0 = cp[0], p1 = cp[1], q0 = cp[DCONV / 4], q1 = cp[DCONV / 4 + 1];
#pragma unroll
                        for (int i = 0; i < 4; ++i) { um2[i] = p0[i]; um2[4 + i] = p1[i]; um1[i] = q0[i]; um1[4 + i] = q1[i]; }
                    }
#pragma unroll
                    for (int p = 0; p < 4; ++p) {
                        float u[8], bv[8], a[8];
                        CONV_U(u, cc[2 + p], xx[2 + p]);
                        const v4u b4 = bb[p];
                        bv[0] = bf_lo(b4.x); bv[1] = bf_hi(b4.x); bv[2] = bf_lo(b4.y); bv[3] = bf_hi(b4.y); bv[4] = bf_lo(b4.z); bv[5] = bf_hi(b4.z); bv[6] = bf_lo(b4.w); bv[7] = bf_hi(b4.w);
#pragma unroll
                        for (int i = 0; i < 8; ++i) { a[i] = bv[i] * (w0[i] * um2[i] + w1[i] * um1[i] + w2[i] * u[i]); um2[i] = um1[i]; um1[i] = u[i]; }
                        v4u o; o.x = pk2(a[0], a[1]); o.y = pk2(a[2], a[3]); o.z = pk2(a[4], a[5]); o.w = pk2(a[6], a[7]);
                        *(GAS v4u*)(ABR + (size_t)(r0 + p) * KBR + c0) = o;
                    }
#undef CONV_U
                    if (tpos + 4 == slen) {
                        float* co = prompt ? out + O_CP + ((size_t)(L * NB + sb) * 2) * DCONV + c0 : out + O_CS + ((size_t)(L * DB + sb) * 2) * DCONV + c0;
#pragma unroll
                        for (int i = 0; i < 8; ++i) { co[i] = um2[i]; co[DCONV + i] = um1[i]; }
                    }
                }
            }
            SEAM(pb + 2);
        }
        if (IN(pb + 3) && !SKIP_GBR) {
            PHASE_TID();
            pg8::Gemm g{ABR, WL + LW_BR / 2, MP, DM, KBR}; pg8::StaticOrder S; S.init(MP, DM, Gq, bxq, 2, MP);
            pg8::EpiBr E{GG, MB};
            pg8::gemm_phase<pg8::EpiBr, pg8::StaticOrder, true, true, true>(ldsl + RING_OFF, g, S, E);
            SEAM(pb + 3);
        }
        if (IN(pb + 4) && !SKIP_GOUT) {
            PHASE_TID();
            pg8::Gemm g{MB, WL + LW_OUT / 2, MP, DM, DM}; pg8::StaticOrder S; S.init(MP, DM, Gq, bxq, 1, MP);
            pg8::EpiResT<false> E{X, nullptr, nullptr, 0, 0, SS(3 * L + 1), LQ};
            pg8::gemm_phase<pg8::EpiResT<false>, pg8::StaticOrder, true, true, true>(ldsl + RING_OFF, g, S, E);
            SEAM(pb + 4);
        }
        if (IN(pb + 5) && !SKIP_GUP) {
            PHASE_TID();
            pg8::Gemm g{X, WL + LW_13 / 2, M, NUP, DM}; pg8::StaticOrder S; S.init(M, NUP, Gq, bxq);
            pg8::EpiUp E{ACT, SS(3 * L + 1)};
            pg8::gemm_phase<pg8::EpiUp, pg8::StaticOrder, true, true>(ldsl + RING_OFF, g, S, E);
            if (L + 1 < DEPTH) { KV_TAIL((M / 256) * (NUP / 256), KV_F1, KV_F2, L + 1); }
            SEAM(pb + 5);
        }
        if (IN(pb + 6) && !SKIP_GDN) {
            PHASE_TID();
            pg8::Gemm g{ACT, WL + LW_2 / 2, MP, DM, DFF}; pg8::StaticOrder S; S.init(MP, DM, Gq, bxq, 1, MP);
            pg8::EpiResT<true> E{X, ka->in[23] + (size_t)L * DM, APLE, KPLE, DPLE, SS(3 * L + 2), LQ};
            pg8::gemm_phase<pg8::EpiResT<true>, pg8::StaticOrder, true, true, true>(ldsl + RING_OFF, g, S, E);
            SEAM(pb + 6);
        }
        if (IN(pb + 7) && !SKIP_GPLE) {
            PHASE_TID();
            pg8::Gemm g{APLE, WL + LW_PLE / 2, MP, DM, KPLE}; pg8::StaticOrder S; S.init(MP, DM, Gq, bxq, 2, MP);
            pg8::EpiPle E{X, PP, SS(3 * L + 2), L + 1 < DEPTH ? ka->in[8] : nullptr, nullptr, L + 1 < DEPTH ? SS(3 * L + 3) : nullptr, LQ};
            pg8::gemm_phase<pg8::EpiPle, pg8::StaticOrder, true, true, true>(ldsl + RING_OFF, g, S, E);
            SEAM(pb + 7);
        }
    }
    if (IN(PH_FINAL)) {
        PHASE_TID();
        const float* gain = ka->in[26];
        for (int m = gw; m < M; m += NGW) {
            const GAS v2u* xr = (const GAS v2u*)(X + (size_t)m * DM) + lane; f32x4 v[8]; float sq = 0.f;
#pragma unroll
            for (int j = 0; j < 8; ++j) { const v2u w_ = xr[64 * j]; v[j] = (f32x4){bf_lo(w_.x), bf_hi(w_.x), bf_lo(w_.y), bf_hi(w_.y)}; sq += (v[j].x * v[j].x + v[j].y * v[j].y) + (v[j].z * v[j].z + v[j].w * v[j].w); }
            const float rstd = 1.f / sqrtf(wave_sum(sq) * (1.f / DM) + EPS);
            const GAS f32x4* gr = (const GAS f32x4*)gain + lane; GAS f32x4* o = (GAS f32x4*)(out + O_YP + (size_t)m * DM) + lane;
#pragma unroll
            for (int j = 0; j < 8; ++j) __builtin_nontemporal_store(v[j] * rstd * gr[64 * j], &o[64 * j]);
        }
    }
#undef IN
#undef SEAM
}

#ifndef MK_PER_PHASE
#define MK_PER_PHASE 0
#endif
extern "C" void kernel_launch(void* const* d_in, const int* in_sizes, int n_in, void* d_out, int out_size, void* d_ws, size_t ws_size, hipStream_t stream) {
    static int grid = 0;
    if (grid == 0) {
        if (n_in != 27 || in_sizes[0] != MP * DM || (size_t)out_size != O_END || ws_size < WS_END) {
            fprintf(stderr, "kernel_launch: shape mismatch: n_in %d in0 %d out %d ws %zu (need %zu); nothing launched\n", n_in, n_in > 0 ? in_sizes[0] : -1, out_size, ws_size, (size_t)WS_END); grid = -1; return; }
        int dev = 0, cus = 0, per_cu = 0;
        if (hipGetDevice(&dev) != hipSuccess || hipDeviceGetAttribute(&cus, hipDeviceAttributeMultiprocessorCount, dev) != hipSuccess) { fprintf(stderr, "kernel_launch: device query failed\n"); grid = -1; return; }
        if (hipFuncSetAttribute((const void*)trunk_fwd, hipFuncAttributeMaxDynamicSharedMemorySize, LDS_BYTES) != hipSuccess) { fprintf(stderr, "kernel_launch: hipFuncSetAttribute failed\n"); grid = -1; return; }
        if (hipOccupancyMaxActiveBlocksPerMultiprocessor(&per_cu, (const void*)trunk_fwd, NWAVES * 64, LDS_BYTES) != hipSuccess || per_cu < 1)
            fprintf(stderr, "kernel_launch: note: occupancy query reports %d workgroups per CU\n", per_cu);
        (void)hipGetLastError();
        grid = cus;
    }
    if (grid < 0) return;
    if (hipMemsetAsync((char*)d_ws + WS_CTL, 0, CTL_ZERO_BYTES, stream) != hipSuccess) { fprintf(stderr, "kernel_launch: memset failed\n"); return; }
    Args a{};
    for (int i = 0; i < 27; ++i) a.in[i] = (const float*)d_in[i];
    a.out = (float*)d_out; a.ws = (unsigned char*)d_ws;
#if MK_PER_PHASE
    for (int p = 0; p < NPHASES; ++p) { a.ph_lo = p; a.ph_hi = p + 1; hipLaunchKernelGGL(trunk_fwd, dim3(grid), dim3(NWAVES * 64), LDS_BYTES, stream, a); }
#else
    a.ph_lo = 0; a.ph_hi = NPHASES;
    hipLaunchKernelGGL(trunk_fwd, dim3(grid), dim3(NWAVES * 64), LDS_BYTES, stream, a);
#endif
    const hipError_t le = hipPeekAtLastError();
    if (le != hipSuccess) fprintf(stderr, "kernel_launch: launch failed: %s\n", hipGetErrorName(le));
}
```

```cpp
#include <hip/hip_runtime.h>
#include <hip/hip_bf16.h>
#include <cstdio>
#include <cstdint>

constexpr int DM = 2048, NB = 4, SEQ = 2048, DEPTH = 4, DB = 8, DSEQ = 64, PAST = 1024;
constexpr int DCONV = 1024, NH = 8, HD = 128, DATTN = 2048, DFF = 5632, DPLE = 256, DIN = 13312;
constexpr int MP = NB * SEQ, MS = DB * DSEQ, M = MP + MS;
constexpr int KROWS = 1152;
constexpr float EPS = 1e-6f;
constexpr int KBR = DCONV + DATTN;
constexpr int KPLE = DPLE + DM;
constexpr int NUP = 2 * DFF;

constexpr size_t MiB = 1u << 20;
constexpr size_t alignMiB(size_t x) { return (x + MiB - 1) / MiB * MiB; }
constexpr size_t WS_CTL = 0, CTL_ZERO_BYTES = 32768;
constexpr size_t LW_IN = 0, LW_BR = LW_IN + (size_t)DIN * DM * 2, LW_OUT = LW_BR + (size_t)DM * KBR * 2, LW_13 = LW_OUT + (size_t)DM * DM * 2,
                 LW_2 = LW_13 + (size_t)NUP * DM * 2, LW_PLE = LW_2 + (size_t)DM * DFF * 2, LW_BYTES = LW_PLE + (size_t)DM * KPLE * 2;
constexpr size_t WS_W = 1 * MiB;
constexpr size_t WS_KALL = WS_W + DEPTH * LW_BYTES;
constexpr size_t KALL_BYTES = (size_t)DEPTH * DB * KROWS * DM * 2;
constexpr size_t WS_VALL = WS_KALL + KALL_BYTES;
constexpr size_t WS_X = WS_VALL + KALL_BYTES;
constexpr size_t WS_AH = alignMiB(WS_X + (size_t)M * DM * 4);
constexpr size_t WS_APLE = alignMiB(WS_AH + (size_t)M * DM * 2);
constexpr size_t APLE_BYTES = alignMiB((size_t)M * KPLE * 2);
constexpr size_t WS_ZC = WS_APLE + DEPTH * APLE_BYTES;
constexpr size_t WS_QB = alignMiB(WS_ZC + (size_t)M * 3072 * 2);
constexpr size_t WS_KB = alignMiB(WS_QB + (size_t)(M + 256) * DM * 2);
constexpr size_t WS_VB = alignMiB(WS_KB + (size_t)MP * DM * 2);
constexpr size_t WS_GG = alignMiB(WS_VB + (size_t)MP * DM * 2);
constexpr size_t WS_OP = alignMiB(WS_GG + (size_t)M * 4096 * 2);
constexpr size_t WS_ABR = alignMiB(WS_OP + (size_t)2 * M * DM * 4);
constexpr size_t WS_MB = alignMiB(WS_ABR + (size_t)M * KBR * 2);
constexpr size_t WS_ACT = WS_OP;
constexpr size_t WS_PP = alignMiB(WS_MB + (size_t)M * DM * 2);
constexpr size_t WS_SSP = alignMiB(WS_PP + (size_t)M * DM * 4);
constexpr size_t WS_END = alignMiB(WS_SSP + (size_t)13 * M * 8 * 4);
constexpr size_t O_YP = 0, O_YS = O_YP + (size_t)MP * DM, O_KP = O_YS + (size_t)MS * DM, O_VP = O_KP + (size_t)DEPTH * MP * DM, O_CP = O_VP + (size_t)DEPTH * MP * DM,
                 O_KS = O_CP + (size_t)DEPTH * NB * 2 * DCONV, O_VS = O_KS + (size_t)DEPTH * MS * DM, O_CS = O_VS + (size_t)DEPTH * MS * DM, O_END = O_CS + (size_t)DEPTH * DB * 2 * DCONV;
static_assert(O_END == 160530432, "output size");
constexpr int CW_BAR = 4096;
constexpr int NSS = 3 * DEPTH + 1;
static_assert((size_t)M * DFF * 2 <= (size_t)2 * M * DM * 4, "ACT fits over OP");

constexpr int RING_OFF = 0, RING_BYTES = 131072;
constexpr int LDSCTL_OFF = 162816, MISC_OFF = LDSCTL_OFF + 320;
constexpr int LDS_SSQ = 131072 + 4096;
constexpr int LDS_BYTES = 163840;
constexpr int NWAVES = 8;

#define GAS __attribute__((address_space(1)))
#define LAS __attribute__((address_space(3)))
typedef unsigned short bf16;
typedef unsigned v4u __attribute__((ext_vector_type(4)));
typedef unsigned v2u __attribute__((ext_vector_type(2)));
typedef float f32x4 __attribute__((ext_vector_type(4)));
#define LDS_WAIT() asm volatile("s_waitcnt lgkmcnt(0)" ::: "memory")
#define VM_WAIT() asm volatile("s_waitcnt vmcnt(0)" ::: "memory")
__device__ __forceinline__ unsigned f2bf(float f) { unsigned u = __builtin_bit_cast(unsigned, f); return (u + 0x7fffu + ((u >> 16) & 1u)) >> 16; }
__device__ __forceinline__ unsigned pk2(float lo, float hi) { return f2bf(lo) | (f2bf(hi) << 16); }
__device__ __forceinline__ float bf_lo(unsigned w) { return __builtin_bit_cast(float, w << 16); }
__device__ __forceinline__ float bf_hi(unsigned w) { return __builtin_bit_cast(float, w & 0xffff0000u); }
__device__ __forceinline__ float wave_sum(float v) {
#define WS_SWZ(K) v += __builtin_bit_cast(float, __builtin_amdgcn_ds_swizzle(__builtin_bit_cast(int, v), ((K) << 10) | 0x1f))
    WS_SWZ(1); WS_SWZ(2); WS_SWZ(4); WS_SWZ(8); WS_SWZ(16);
#undef WS_SWZ
    const unsigned u = __builtin_bit_cast(unsigned, v); unsigned u2 = u; asm volatile("" : "+v"(u2));
    auto rr = __builtin_amdgcn_permlane32_swap(u, u2, false, false);
    const unsigned r0 = rr[0], r1 = rr[1];
    return __uint_as_float(r0) + __uint_as_float(r1);
}
__device__ __forceinline__ float half_sum(float v) {
#define WS_SWZ(K) v += __builtin_bit_cast(float, __builtin_amdgcn_ds_swizzle(__builtin_bit_cast(int, v), ((K) << 10) | 0x1f))
    WS_SWZ(1); WS_SWZ(2); WS_SWZ(4); WS_SWZ(8); WS_SWZ(16);
#undef WS_SWZ
    return v;
}
__device__ __forceinline__ float fast_exp(float x) { return __builtin_amdgcn_exp2f(x * 1.4426950408889634f); }
__device__ __forceinline__ float sigmoidf(float x) { return __builtin_amdgcn_rcpf(1.f + fast_exp(-x)); }
namespace pg8 {
#define PG8_LAS __attribute__((address_space(3)))
typedef unsigned short bf16_t;
typedef short bf16x8 __attribute__((ext_vector_type(8)));
typedef float f32x4 __attribute__((ext_vector_type(4)));
typedef unsigned u32x4 __attribute__((ext_vector_type(4)));
constexpr int BM = 256, BK = 64, HALF = 128, HTB = HALF * BK * 2  , STAGE_BYTES = 8 * HTB, NXCD = 8, WGM = 8;

__host__ __device__ __forceinline__ int lds_byte(int r, int c) { const int st = (r >> 4) * 2 + (c >> 5), rr = r & 15, cc = c & 31, ob = rr * 64 + cc * 2; return st * 1024 + (ob ^ (((ob >> 9) & 1) << 5)); }
__host__ __device__ __forceinline__ void stage_rc(int b, int& R, int& C) { const int st = b / 1024, sb = b % 1024, swz = sb ^ (((sb >> 9) & 1) << 5); R = (st >> 1) * 16 + swz / 64; C = (st & 1) * 32 + (swz % 64) / 2; }
__host__ __device__ __forceinline__ int perm32(int rho) { const int n = rho >> 4, i = rho & 15; return 8 * (i >> 2) + 4 * n + (i & 3); }

struct Unit { int pm, pn, seg; };
struct Gemm { const bf16_t* A; const bf16_t* Bt; int M, N, K; };

struct StaticOrder {
    int nM, nN, nwg, G, c, nseg, srow0;
    __host__ __device__ void init(int M, int N, int G_, int c_, int nseg_ = 1, int srow0_ = 0) { nM = M / BM; nN = N / BM; nwg = nM * nN; G = G_; c = c_; nseg = nseg_; srow0 = srow0_; }
    __host__ __device__ bool next(int i, Unit& u) const {
        const int rnd = nseg == 1 ? i : (i >> 1); u.seg = nseg == 1 ? 0 : (i & 1);
        const long L = (long)rnd * G + c; if (L >= nwg) return false;
        int wgid = (int)L; { const int q = nwg / NXCD, r = nwg % NXCD, xcd = wgid % NXCD, off = wgid / NXCD; wgid = (xcd < r ? xcd * (q + 1) : r * (q + 1) + (xcd - r) * q) + off; }
        const int nig = WGM * nN, gid = wgid / nig, fm = gid * WGM, gsz = (nM - fm) < WGM ? (nM - fm) : WGM;
        u.pm = fm + ((wgid % nig) % gsz); u.pn = (wgid % nig) / gsz; return true;
    }
    __device__ __forceinline__ void a_ready(const Unit&) const {}
    __device__ __forceinline__ void done(const Unit&) const {}
};

typedef unsigned u32x2 __attribute__((ext_vector_type(2)));
__device__ __forceinline__ unsigned cvt_pk_bf16(float lo, float hi) { unsigned r; asm volatile("v_cvt_pk_bf16_f32 %0, %1, %2" : "=v"(r) : "v"(lo), "v"(hi)); return r; }
__device__ __forceinline__ u32x4 pack8(const f32x4& a, const f32x4& b) { u32x4 w; w.x = cvt_pk_bf16(a[0], a[1]); w.y = cvt_pk_bf16(a[2], a[3]); w.z = cvt_pk_bf16(b[0], b[1]); w.w = cvt_pk_bf16(b[2], b[3]); return w; }
__device__ __forceinline__ float ex2(float x) { return __builtin_amdgcn_exp2f(x); }
__device__ __forceinline__ float expneg(float g) { return ex2(fminf(-g * 1.4426950408889634f, 80.f)); }
__device__ __forceinline__ float bflo(unsigned w) { return __builtin_bit_cast(float, w << 16); }
__device__ __forceinline__ float bfhi(unsigned w) { return __builtin_bit_cast(float, w & 0xffff0000u); }

#define PG8_ONE_SEG static __device__ __forceinline__ int k0(int) { return 0; } static __device__ __forceinline__ int nt(int, int K) { return K / BK; } static __device__ __forceinline__ bool final_seg(int) { return true; }
__device__ __forceinline__ float ss_total(const u32x4 a) { return ((bflo(a.x) + bfhi(a.x)) + (bflo(a.y) + bfhi(a.y))) + ((bflo(a.z) + bfhi(a.z)) + (bflo(a.w) + bfhi(a.w))); }
__device__ __forceinline__ float row_rstd(const bf16_t* ss, int row) { const u32x4 a = *(const u32x4*)(ss + (size_t)row * 8);
    return __builtin_amdgcn_rsqf(ss_total(a) * (1.f / 2048.f) + 1e-6f); }
__device__ __forceinline__ bf16_t ss_bf16(float f) { const unsigned u = __builtin_bit_cast(unsigned, f); return (bf16_t)((u + 0x7fffu + ((u >> 16) & 1u)) >> 16); }
__device__ __forceinline__ float fq_sum(float q) {
    q += __builtin_bit_cast(float, __builtin_amdgcn_ds_swizzle(__builtin_bit_cast(int, q), (16 << 10) | 0x1f));
    const unsigned u = __float_as_uint(q); unsigned u2 = u; asm volatile("" : "+v"(u2)); auto rr = __builtin_amdgcn_permlane32_swap(u, u2, false, false); const unsigned r0 = rr[0], r1 = rr[1];
    return __uint_as_float(r0) + __uint_as_float(r1);
}
#define PG8_SS_FINISH __device__ __forceinline__ void finish(const Unit& u, int srow0, int tid) const { \
        asm volatile("s_waitcnt lgkmcnt(0)" ::: "memory"); __builtin_amdgcn_s_barrier(); asm volatile("" ::: "memory"); \
        if (ss) { if (tid < 256) { const float s = (lq[tid] + lq[256 + tid]) + (lq[512 + tid] + lq[768 + tid]); ss[(size_t)(u.pm * BM + tid) * 8 + u.pn] = ss_bf16(s); } \
            else if (tid < 272) { const int r = tid - 256; PG8_LAS const float* p = lq + 1024 + r; const float s = ((p[0] + p[16]) + (p[32] + p[48])) + ((p[64] + p[80]) + (p[96] + p[112])); ss[(size_t)(srow0 + 16 * u.pm + r) * 8 + u.pn] = ss_bf16(s); } } }
#define PG8_NO_FINISH __device__ __forceinline__ void finish(const Unit&, int, int) const {}
struct EpiIn {
    static constexpr bool PERM = true, AFTER_DRAIN = false; PG8_ONE_SEG
    PG8_NO_FINISH
    unsigned char* ws; float* out; int L; const bf16_t* ss;
    __device__ __forceinline__ void mid(f32x4 (&)[2][2][4][2], const Unit&, int, int, int, int) const {}
    __device__ __forceinline__ void operator()(const f32x4 (&acc)[2][2][4][2], const Unit& u, int wr, int wc, int fr, int fq) const {
        const int pn = u.pn, rowt = u.pm * BM + wr * 64 + fr, colw = wc * 32 + 8 * fq;
        float rsv[2][4];
#pragma unroll
        for (int ai = 0; ai < 2; ++ai)
#pragma unroll
            for (int m = 0; m < 4; ++m) rsv[ai][m] = row_rstd(ss, rowt + ai * HALF + m * 16);
        if (pn < 20 || pn >= 36) {
            bf16_t* base; int ld, colt;
            if (pn < 12) { base = (bf16_t*)(ws + WS_ZC); ld = 3072; colt = pn * 256; }
            else if (pn < 20) { base = (bf16_t*)(ws + WS_QB); ld = 2048; colt = (pn - 12) * 256; }
            else { base = (bf16_t*)(ws + WS_GG); ld = 4096; colt = (pn - 36) * 256; }
#pragma unroll
            for (int ai = 0; ai < 2; ++ai)
#pragma unroll
                for (int m = 0; m < 4; ++m) { const int row = rowt + ai * HALF + m * 16; bf16_t* rowp = base + (size_t)row * ld + colt + colw; const float rs = rsv[ai][m];
#pragma unroll
                    for (int bj = 0; bj < 2; ++bj) *(u32x4*)(rowp + bj * HALF) = pack8(acc[ai][bj][m][0] * rs, acc[ai][bj][m][1] * rs); }
        } else {
            const bool isv = pn >= 28; const int colt = (pn - (isv ? 28 : 20)) * 256 + colw;
            float* fbase; bf16_t* bbase;
            if (u.pm < 32) { fbase = out + (isv ? O_VP : O_KP) + (size_t)L * MP * DM; bbase = (bf16_t*)(ws + (isv ? WS_VB : WS_KB)); }
            else { fbase = out + (isv ? O_VS : O_KS) + (size_t)L * MS * DM; bbase = (bf16_t*)(ws + (isv ? WS_VALL : WS_KALL)) + (size_t)L * DB * KROWS * DM; }
#pragma unroll
            for (int ai = 0; ai < 2; ++ai)
#pragma unroll
                for (int m = 0; m < 4; ++m) { const int row = rowt + ai * HALF + m * 16; size_t fo, bo; const float rs = rsv[ai][m];
                    if (u.pm < 32) { fo = (size_t)row * 2048 + colt; bo = fo; }
                    else { const int rs = row - 8192, b = rs >> 6, s = rs & 63; fo = (size_t)rs * 2048 + colt; bo = ((size_t)b * KROWS + 1024 + s) * 2048 + colt; }
#pragma unroll
                    for (int bj = 0; bj < 2; ++bj) { const f32x4 v0 = acc[ai][bj][m][0] * rs, v1 = acc[ai][bj][m][1] * rs; __builtin_nontemporal_store(v0, (f32x4*)(fbase + fo + bj * HALF)); __builtin_nontemporal_store(v1, (f32x4*)(fbase + fo + bj * HALF + 4));
                        *(u32x4*)(bbase + bo + bj * HALF) = pack8(v0, v1); }
                    asm volatile("" ::: "memory"); }
        }
    }
};
struct EpiBr {
    static constexpr bool PERM = true, AFTER_DRAIN = false;
    static __device__ __forceinline__ int k0(int seg) { return seg ? 1024 : 0; }
    static __device__ __forceinline__ int nt(int seg, int) { return seg ? 32 : 16; }
    static __device__ __forceinline__ bool final_seg(int seg) { return seg != 0; }
    PG8_NO_FINISH
    const bf16_t* gg; bf16_t* mb;
    __device__ __forceinline__ void mid(f32x4 (&acc)[2][2][4][2], const Unit& u, int wr, int wc, int fr, int fq) const {
        const int rowt = u.pm * BM + wr * 64 + fr, col0 = u.pn * BM + wc * 32 + 8 * fq;
#define PG8_RATIO(A, B) ((1.f + expneg(B)) * __builtin_amdgcn_rcpf(1.f + expneg(A)))
#pragma unroll
        for (int ai = 0; ai < 2; ++ai) {
            u32x4 ga[4][2], gb[4][2];
#pragma unroll
            for (int m = 0; m < 4; ++m) { const bf16_t* rowp = gg + (size_t)(rowt + ai * HALF + m * 16) * 4096 + col0;
#pragma unroll
                for (int bj = 0; bj < 2; ++bj) { ga[m][bj] = *(const u32x4*)(rowp + bj * HALF); gb[m][bj] = *(const u32x4*)(rowp + 2048 + bj * HALF); } }
            asm volatile("" ::: "memory");
#pragma unroll
            for (int m = 0; m < 4; ++m)
#pragma unroll
                for (int bj = 0; bj < 2; ++bj) { const u32x4 a = ga[m][bj], b = gb[m][bj];
                    acc[ai][bj][m][0][0] *= PG8_RATIO(bflo(a.x), bflo(b.x)); acc[ai][bj][m][0][1] *= PG8_RATIO(bfhi(a.x), bfhi(b.x));
                    acc[ai][bj][m][0][2] *= PG8_RATIO(bflo(a.y), bflo(b.y)); acc[ai][bj][m][0][3] *= PG8_RATIO(bfhi(a.y), bfhi(b.y));
                    acc[ai][bj][m][1][0] *= PG8_RATIO(bflo(a.z), bflo(b.z)); acc[ai][bj][m][1][1] *= PG8_RATIO(bfhi(a.z), bfhi(b.z));
                    acc[ai][bj][m][1][2] *= PG8_RATIO(bflo(a.w), bflo(b.w)); acc[ai][bj][m][1][3] *= PG8_RATIO(bfhi(a.w), bfhi(b.w)); }
            asm volatile("" ::: "memory");
        }
#undef PG8_RATIO
    }
    __device__ __forceinline__ void operator()(const f32x4 (&acc)[2][2][4][2], const Unit& u, int wr, int wc, int fr, int fq) const {
        const int rowt = u.pm * BM + wr * 64 + fr, col0 = u.pn * BM + wc * 32 + 8 * fq;
#define PG8_SB(B) __builtin_amdgcn_rcpf(1.f + expneg(B))
        u32x4 gb[2][4][2];
#pragma unroll
        for (int ai = 0; ai < 2; ++ai)
#pragma unroll
            for (int m = 0; m < 4; ++m)
#pragma unroll
                for (int bj = 0; bj < 2; ++bj) gb[ai][m][bj] = *(const u32x4*)(gg + (size_t)(rowt + ai * HALF + m * 16) * 4096 + 2048 + col0 + bj * HALF);
        asm volatile("" ::: "memory");
#pragma unroll
        for (int ai = 0; ai < 2; ++ai)
#pragma unroll
            for (int m = 0; m < 4; ++m) { const size_t r = (size_t)(rowt + ai * HALF + m * 16);
#pragma unroll
                for (int bj = 0; bj < 2; ++bj) { const u32x4 b = gb[ai][m][bj];
                    f32x4 v0 = acc[ai][bj][m][0], v1 = acc[ai][bj][m][1];
                    v0[0] *= PG8_SB(bflo(b.x)); v0[1] *= PG8_SB(bfhi(b.x)); v0[2] *= PG8_SB(bflo(b.y)); v0[3] *= PG8_SB(bfhi(b.y));
                    v1[0] *= PG8_SB(bflo(b.z)); v1[1] *= PG8_SB(bfhi(b.z)); v1[2] *= PG8_SB(bflo(b.w)); v1[3] *= PG8_SB(bfhi(b.w));
                    *(u32x4*)(mb + r * 2048 + col0 + bj * HALF) = pack8(v0, v1); } }
#undef PG8_SB
    }
    __device__ __forceinline__ void sliver_mid(f32x4 (&accs)[2], const Unit& u, int srow0, int wr, int wc, int fr, int fq) const {
        const size_t r = (size_t)(srow0 + 16 * u.pm + fr); const int col0 = u.pn * BM + wr * HALF + wc * 32 + 8 * fq;
        const u32x4 a = *(const u32x4*)(gg + r * 4096 + col0), b = *(const u32x4*)(gg + r * 4096 + 2048 + col0);
#define PG8_RATIO(A, B) ((1.f + expneg(B)) * __builtin_amdgcn_rcpf(1.f + expneg(A)))
        accs[0][0] *= PG8_RATIO(bflo(a.x), bflo(b.x)); accs[0][1] *= PG8_RATIO(bfhi(a.x), bfhi(b.x)); accs[0][2] *= PG8_RATIO(bflo(a.y), bflo(b.y)); accs[0][3] *= PG8_RATIO(bfhi(a.y), bfhi(b.y));
        accs[1][0] *= PG8_RATIO(bflo(a.z), bflo(b.z)); accs[1][1] *= PG8_RATIO(bfhi(a.z), bfhi(b.z)); accs[1][2] *= PG8_RATIO(bflo(a.w), bflo(b.w)); accs[1][3] *= PG8_RATIO(bfhi(a.w), bfhi(b.w));
#undef PG8_RATIO
    }
    __device__ __forceinline__ void sliver(const f32x4 (&accs)[2], const Unit& u, int srow0, int wr, int wc, int fr, int fq) const {
        const size_t r = (size_t)(srow0 + 16 * u.pm + fr); const int col0 = u.pn * BM + wr * HALF + wc * 32 + 8 * fq;
        const u32x4 b = *(const u32x4*)(gg + r * 4096 + 2048 + col0);
#define PG8_SB(B) __builtin_amdgcn_rcpf(1.f + expneg(B))
        f32x4 v0 = accs[0], v1 = accs[1];
        v0[0] *= PG8_SB(bflo(b.x)); v0[1] *= PG8_SB(bfhi(b.x)); v0[2] *= PG8_SB(bflo(b.y)); v0[3] *= PG8_SB(bfhi(b.y));
        v1[0] *= PG8_SB(bflo(b.z)); v1[1] *= PG8_SB(bfhi(b.z)); v1[2] *= PG8_SB(bflo(b.w)); v1[3] *= PG8_SB(bfhi(b.w));
#undef PG8_SB
        *(u32x4*)(mb + r * 2048 + col0) = pack8(v0, v1);
    }
};
__device__ __forceinline__ void norm_out(const f32x4& o, const float* gain, bf16_t* dst, size_t doff, int col, float& q) {
    q += (o[0] * o[0] + o[1] * o[1]) + (o[2] * o[2] + o[3] * o[3]);
    const f32x4 g = *(const f32x4*)(gain + col); u32x2 w; w.x = cvt_pk_bf16(o[0] * g[0], o[1] * g[1]); w.y = cvt_pk_bf16(o[2] * g[2], o[3] * g[3]);
    *(u32x2*)(dst + doff + col) = w;
}
template <bool DST> struct EpiResT {
    static constexpr bool PERM = true, AFTER_DRAIN = false; PG8_ONE_SEG
    bf16_t* X; const float* gain; bf16_t* dst; int ldd, dcol; bf16_t* ss; PG8_LAS float* lq;
    __device__ __forceinline__ void mid(f32x4 (&)[2][2][4][2], const Unit&, int, int, int, int) const {}
    __device__ __forceinline__ void operator()(const f32x4 (&acc)[2][2][4][2], const Unit& u, int wr, int wc, int fr, int fq) const {
        const int rowt = u.pm * BM + wr * 64 + fr, col0 = u.pn * BM + wc * 32 + 8 * fq;
        f32x4 gv[2][2];
#pragma unroll
        for (int bj = 0; bj < 2; ++bj)
#pragma unroll
            for (int n = 0; n < 2; ++n) gv[bj][n] = DST ? *(const f32x4*)(gain + col0 + bj * HALF + n * 4) : (f32x4){0.f, 0.f, 0.f, 0.f};
#pragma unroll
        for (int ai = 0; ai < 2; ++ai) {
            u32x4 xv[4][2];
#pragma unroll
            for (int m = 0; m < 4; ++m)
#pragma unroll
                for (int bj = 0; bj < 2; ++bj) xv[m][bj] = *(const u32x4*)(X + (size_t)(rowt + ai * HALF + m * 16) * 2048 + col0 + bj * HALF);
            asm volatile("" ::: "memory");
#pragma unroll
            for (int m = 0; m < 4; ++m) { const int row = rowt + ai * HALF + m * 16; float q = 0.f;
#pragma unroll
                for (int bj = 0; bj < 2; ++bj) { const int col = col0 + bj * HALF; const u32x4 xw = xv[m][bj];
                    const f32x4 o0 = (f32x4){bflo(xw.x), bfhi(xw.x), bflo(xw.y), bfhi(xw.y)} + acc[ai][bj][m][0], o1 = (f32x4){bflo(xw.z), bfhi(xw.z), bflo(xw.w), bfhi(xw.w)} + acc[ai][bj][m][1];
                    *(u32x4*)(X + (size_t)row * 2048 + col) = pack8(o0, o1);
                    q += ((o0[0] * o0[0] + o0[1] * o0[1]) + (o0[2] * o0[2] + o0[3] * o0[3])) + ((o1[0] * o1[0] + o1[1] * o1[1]) + (o1[2] * o1[2] + o1[3] * o1[3]));
                    if constexpr (DST) *(u32x4*)(dst + (size_t)row * ldd + dcol + col) = pack8(o0 * gv[bj][0], o1 * gv[bj][1]); }
                q = fq_sum(q); if (fq == 0) lq[wc * 256 + ai * HALF + wr * 64 + m * 16 + fr] = q; }
            asm volatile("" ::: "memory");
        }
    }
    __device__ __forceinline__ void sliver_mid(f32x4 (&)[2], const Unit&, int, int, int, int, int) const {}
    __device__ __forceinline__ void sliver(const f32x4 (&accs)[2], const Unit& u, int srow0, int wr, int wc, int fr, int fq) const {
        const int row = srow0 + 16 * u.pm + fr, col = u.pn * BM + wr * HALF + wc * 32 + 8 * fq;
        const u32x4 xw = *(const u32x4*)(X + (size_t)row * 2048 + col);
        const f32x4 o0 = (f32x4){bflo(xw.x), bfhi(xw.x), bflo(xw.y), bfhi(xw.y)} + accs[0], o1 = (f32x4){bflo(xw.z), bfhi(xw.z), bflo(xw.w), bfhi(xw.w)} + accs[1];
        *(u32x4*)(X + (size_t)row * 2048 + col) = pack8(o0, o1);
        float q = ((o0[0] * o0[0] + o0[1] * o0[1]) + (o0[2] * o0[2] + o0[3] * o0[3])) + ((o1[0] * o1[0] + o1[1] * o1[1]) + (o1[2] * o1[2] + o1[3] * o1[3]));
        if constexpr (DST) { const f32x4 g0 = *(const f32x4*)(gain + col), g1 = *(const f32x4*)(gain + col + 4); *(u32x4*)(dst + (size_t)row * ldd + dcol + col) = pack8(o0 * g0, o1 * g1); }
        q = fq_sum(q); if (fq == 0) lq[1024 + (wr * 4 + wc) * 16 + fr] = q;
    }
    PG8_SS_FINISH
};
struct EpiUp {
    static constexpr bool PERM = true, AFTER_DRAIN = false; PG8_ONE_SEG
    PG8_NO_FINISH
    bf16_t* act; const bf16_t* ss;
    __device__ __forceinline__ void mid(f32x4 (&)[2][2][4][2], const Unit&, int, int, int, int) const {}
    __device__ __forceinline__ void operator()(const f32x4 (&acc)[2][2][4][2], const Unit& u, int wr, int wc, int fr, int fq) const {
        const int rowt = u.pm * BM + wr * 64 + fr, col0 = u.pn * HALF + wc * 32 + 8 * fq;
        float rsv[2][4];
#pragma unroll
        for (int ai = 0; ai < 2; ++ai)
#pragma unroll
            for (int m = 0; m < 4; ++m) rsv[ai][m] = row_rstd(ss, rowt + ai * HALF + m * 16);
#pragma unroll
        for (int ai = 0; ai < 2; ++ai)
#pragma unroll
            for (int m = 0; m < 4; ++m) { f32x4 v[2]; const float rs = rsv[ai][m];
#pragma unroll
                for (int n = 0; n < 2; ++n)
#pragma unroll
                    for (int i = 0; i < 4; ++i) { const float g = acc[ai][0][m][n][i] * rs; v[n][i] = g * __builtin_amdgcn_rcpf(1.f + expneg(g)) * (acc[ai][1][m][n][i] * rs); }
                *(u32x4*)(act + (size_t)(rowt + ai * HALF + m * 16) * 5632 + col0) = pack8(v[0], v[1]); }
    }
};
struct EpiPle {
    static constexpr bool PERM = true, AFTER_DRAIN = false;
    static __device__ __forceinline__ int k0(int seg) { return seg ? 256 : 0; }
    static __device__ __forceinline__ int nt(int seg, int) { return seg ? 32 : 4; }
    static __device__ __forceinline__ bool final_seg(int seg) { return seg != 0; }
    bf16_t* X; bf16_t* PP; const bf16_t* ss3; const float* gain; bf16_t* dst; bf16_t* ss; PG8_LAS float* lq;
    __device__ __forceinline__ void mid(f32x4 (&acc)[2][2][4][2], const Unit& u, int wr, int wc, int fr, int fq) const {
        const int rowt = u.pm * BM + wr * 64 + fr, col0 = u.pn * BM + wc * 32 + 8 * fq;
#pragma unroll
        for (int ai = 0; ai < 2; ++ai)
#pragma unroll
            for (int m = 0; m < 4; ++m) { bf16_t* rowp = PP + (size_t)(rowt + ai * HALF + m * 16) * 2048 + col0;
#pragma unroll
                for (int bj = 0; bj < 2; ++bj) { *(u32x4*)(rowp + bj * HALF) = pack8(acc[ai][bj][m][0], acc[ai][bj][m][1]); acc[ai][bj][m][0] = (f32x4){0.f, 0.f, 0.f, 0.f}; acc[ai][bj][m][1] = (f32x4){0.f, 0.f, 0.f, 0.f}; } }
    }
    __device__ __forceinline__ void operator()(const f32x4 (&acc)[2][2][4][2], const Unit& u, int wr, int wc, int fr, int fq) const {
        const int rowt = u.pm * BM + wr * 64 + fr, col0 = u.pn * BM + wc * 32 + 8 * fq;
        f32x4 gv[2][2];
#pragma unroll
        for (int bj = 0; bj < 2; ++bj)
#pragma unroll
            for (int n = 0; n < 2; ++n) gv[bj][n] = (f32x4){0.f, 0.f, 0.f, 0.f};
#pragma unroll
        for (int ai = 0; ai < 2; ++ai)
#pragma unroll
            for (int mh = 0; mh < 2; ++mh) {
                u32x4 xv[2][2], pv[2][2]; u32x4 sa[2];
#pragma unroll
                for (int m2 = 0; m2 < 2; ++m2) { const int row = rowt + ai * HALF + (mh * 2 + m2) * 16; sa[m2] = *(const u32x4*)(ss3 + (size_t)row * 8);
#pragma unroll
                    for (int bj = 0; bj < 2; ++bj) { const size_t o_ = (size_t)row * 2048 + col0 + bj * HALF; xv[m2][bj] = *(const u32x4*)(X + o_); pv[m2][bj] = *(const u32x4*)(PP + o_); } }
                asm volatile("" ::: "memory");
#pragma unroll
                for (int m2 = 0; m2 < 2; ++m2) { const int m = mh * 2 + m2, row = rowt + ai * HALF + m * 16; float q = 0.f;
                    const float rs = __builtin_amdgcn_rsqf(ss_total(sa[m2]) * (1.f / 2048.f) + 1e-6f);
#pragma unroll
                    for (int bj = 0; bj < 2; ++bj) { const int col = col0 + bj * HALF; const u32x4 xw = xv[m2][bj], pw = pv[m2][bj];
                        const f32x4 x0 = {bflo(xw.x), bfhi(xw.x), bflo(xw.y), bfhi(xw.y)}, x1 = {bflo(xw.z), bfhi(xw.z), bflo(xw.w), bfhi(xw.w)};
                        const f32x4 p0 = {bflo(pw.x), bfhi(pw.x), bflo(pw.y), bfhi(pw.y)}, p1 = {bflo(pw.z), bfhi(pw.z), bflo(pw.w), bfhi(pw.w)};
                        const f32x4 a0 = acc[ai][bj][m][0], a1 = acc[ai][bj][m][1]; f32x4 o0, o1;
#pragma unroll
                        for (int i = 0; i < 4; ++i) { o0[i] = x0[i] + p0[i] * __builtin_amdgcn_rcpf(1.f + expneg(a0[i] * rs)); o1[i] = x1[i] + p1[i] * __builtin_amdgcn_rcpf(1.f + expneg(a1[i] * rs)); }
                        *(u32x4*)(X + (size_t)row * 2048 + col) = pack8(o0, o1);
                        if (gain) q += ((o0[0] * o0[0] + o0[1] * o0[1]) + (o0[2] * o0[2] + o0[3] * o0[3])) + ((o1[0] * o1[0] + o1[1] * o1[1]) + (o1[2] * o1[2] + o1[3] * o1[3])); }
                    if (gain) { q = fq_sum(q); if (fq == 0) lq[wc * 256 + ai * HALF + wr * 64 + m * 16 + fr] = q; } }
                asm volatile("" ::: "memory");
            }
    }
    __device__ __forceinline__ void sliver_mid(f32x4 (&accs)[2], const Unit& u, int srow0, int wr, int wc, int fr, int fq) const {
        bf16_t* rowp = PP + (size_t)(srow0 + 16 * u.pm + fr) * 2048 + u.pn * BM + wr * HALF + wc * 32 + 8 * fq;
        *(u32x4*)rowp = pack8(accs[0], accs[1]); accs[0] = (f32x4){0.f, 0.f, 0.f, 0.f}; accs[1] = (f32x4){0.f, 0.f, 0.f, 0.f};
    }
    __device__ __forceinline__ void sliver(const f32x4 (&accs)[2], const Unit& u, int srow0, int wr, int wc, int fr, int fq) const {
        const int row = srow0 + 16 * u.pm + fr, col = u.pn * BM + wr * HALF + wc * 32 + 8 * fq; const size_t off = (size_t)row * 2048 + col; const float rs = row_rstd(ss3, row);
        const u32x4 xw = *(const u32x4*)(X + off), pw = *(const u32x4*)(PP + off);
        const f32x4 x0 = {bflo(xw.x), bfhi(xw.x), bflo(xw.y), bfhi(xw.y)}, x1 = {bflo(xw.z), bfhi(xw.z), bflo(xw.w), bfhi(xw.w)};
        const f32x4 p0 = {bflo(pw.x), bfhi(pw.x), bflo(pw.y), bfhi(pw.y)}, p1 = {bflo(pw.z), bfhi(pw.z), bflo(pw.w), bfhi(pw.w)}; f32x4 o0, o1;
#pragma unroll
        for (int i = 0; i < 4; ++i) { o0[i] = x0[i] + p0[i] * __builtin_amdgcn_rcpf(1.f + expneg(accs[0][i] * rs)); o1[i] = x1[i] + p1[i] * __builtin_amdgcn_rcpf(1.f + expneg(accs[1][i] * rs)); }
        *(u32x4*)(X + off) = pack8(o0, o1);
        if (gain) { float q = ((o0[0] * o0[0] + o0[1] * o0[1]) + (o0[2] * o0[2] + o0[3] * o0[3])) + ((o1[0] * o1[0] + o1[1] * o1[1]) + (o1[2] * o1[2] + o1[3] * o1[3]));
            q = fq_sum(q); if (fq == 0) lq[1024 + (wr * 4 + wc) * 16 + fr] = q; }
    }
    PG8_SS_FINISH
};
template <class Epi, class Sched, bool ALIGN_EPI = false, bool SP2 = false, bool SLIVER = false>
__device__ __forceinline__ void gemm_phase(PG8_LAS unsigned char* lds, const Gemm g, const Sched& S, const Epi& E) {
    int tid_ = threadIdx.x; asm volatile("" : "+v"(tid_));
    const int tid = tid_, wid = __builtin_amdgcn_readfirstlane(tid >> 6), lane = tid & 63, wr = wid >> 2, wc = wid & 3, fr = lane & 15, fq = lane >> 4;
    const int K = g.K;
    unsigned voffA[2], voffB[2];
#pragma unroll
    for (int i = 0; i < 2; ++i) { int R, C; stage_rc(tid * 16 + i * 8192, R, C); const int Rb = Epi::PERM ? ((R & ~31) + perm32(R & 31)) : R;
        voffA[i] = (unsigned)(R * K + C) * 2u; voffB[i] = (unsigned)(Rb * K + C) * 2u; }
    const size_t kstep = (size_t)(BK * 2);
    const size_t qstep = (size_t)64 * K * 2;
    const size_t hstep = (size_t)HALF * K * 2;
    const size_t tstep = 2 * hstep;
    const unsigned ldsw = (unsigned)wid * 1024u;
    const int aoff = lds_byte(wr * 64 + fr, fq * 8), boff = lds_byte(wc * 32 + fr, fq * 8);
    static_assert(!SLIVER || SP2, "the sliver is built into the SP2 loop only");
    const int sp_ = wid * 64 + lane, srow_ = sp_ >> 5, sch_ = ((sp_ & 31) >> 2) ^ (srow_ & 7);
    const unsigned voffS = (unsigned)(srow_ * K) * 2u + (unsigned)(sch_ * 16 + (sp_ & 3) * 4);
    const int soff0 = fr * 128 + 16 * (fq ^ (fr & 7));
#define PG8_SA(b, h) (((b) * 2 + (h)) * HTB)
#define PG8_SB(b, h) ((4 + (b) * 2 + (h)) * HTB)
#define PG8_STAGE(bufoff, gbase, voff) do { _Pragma("unroll") for (int _i = 0; _i < 2; ++_i) \
        __builtin_amdgcn_global_load_lds((const unsigned*)((const char*)(gbase) + (size_t)_i * qstep + (voff)[0]), (PG8_LAS unsigned*)(lds + (bufoff) + ldsw + _i * 8192), 16, 0, 0); } while (0)
#define PG8_LDA(dst, b, h) do { _Pragma("unroll") for (int m = 0; m < 4; ++m) _Pragma("unroll") for (int k = 0; k < 2; ++k) dst[m][k] = *(const PG8_LAS bf16x8*)(lds + PG8_SA(b, h) + aoff + m * 2048 + k * 1024); } while (0)
#define PG8_LDB(dst, b, h) do { _Pragma("unroll") for (int n = 0; n < 2; ++n) _Pragma("unroll") for (int k = 0; k < 2; ++k) dst[n][k] = *(const PG8_LAS bf16x8*)(lds + PG8_SB(b, h) + boff + n * 2048 + k * 1024); } while (0)
#define PG8_MMA(ai, bj, At, Bt) do { __builtin_amdgcn_s_setprio(1); _Pragma("unroll") for (int m = 0; m < 4; ++m) _Pragma("unroll") for (int n = 0; n < 2; ++n) _Pragma("unroll") for (int k = 0; k < 2; ++k) \
        acc[ai][bj][m][n] = __builtin_amdgcn_mfma_f32_16x16x32_bf16(Bt[n][k], At[m][k], acc[ai][bj][m][n], 0, 0, 0); __builtin_amdgcn_s_setprio(0); } while (0)
#define PG8_WAIT_V(n) asm volatile("s_waitcnt vmcnt(" #n ")" ::: "memory")
#define PG8_WAIT_V89() do { if constexpr (SLIVER) PG8_WAIT_V(9); else PG8_WAIT_V(8); } while (0)
#define PG8_STAGE_S(b, gbase) do { if constexpr (SLIVER) __builtin_amdgcn_global_load_lds((const unsigned*)((const char*)(gbase) + voffS), (PG8_LAS unsigned*)(lds + STAGE_BYTES + (b) * 2048 + wid * 256), 4, 0, 0); } while (0)
#define PG8_LDS_S(b) do { if constexpr (SLIVER) { Sf[0] = *(const PG8_LAS bf16x8*)(lds + STAGE_BYTES + (b) * 2048 + soff0); Sf[1] = *(const PG8_LAS bf16x8*)(lds + STAGE_BYTES + (b) * 2048 + (soff0 ^ 64)); } } while (0)
#define PG8_MMA_S() do { if constexpr (SLIVER) { __builtin_amdgcn_s_setprio(1); if (wr == 0) { _Pragma("unroll") for (int n = 0; n < 2; ++n) _Pragma("unroll") for (int k = 0; k < 2; ++k) accs[n] = __builtin_amdgcn_mfma_f32_16x16x32_bf16(B0[n][k], Sf[k], accs[n], 0, 0, 0); } \
        else { _Pragma("unroll") for (int n = 0; n < 2; ++n) _Pragma("unroll") for (int k = 0; k < 2; ++k) accs[n] = __builtin_amdgcn_mfma_f32_16x16x32_bf16(B1[n][k], Sf[k], accs[n], 0, 0, 0); } __builtin_amdgcn_s_setprio(0); } } while (0)
#define PG8_WAIT_L(n) asm volatile("s_waitcnt lgkmcnt(" #n ")" ::: "memory")
#define PG8_BAR __builtin_amdgcn_s_barrier()
#define PG8_SCHED __builtin_amdgcn_sched_barrier(0)
    Unit cur, nxt; int ui = 0;
    if (!S.next(0, cur)) return;
    f32x4 acc[2][2][4][2];
#pragma unroll
    for (int a = 0; a < 2; ++a)
#pragma unroll
        for (int b = 0; b < 2; ++b)
#pragma unroll
            for (int m = 0; m < 4; ++m)
#pragma unroll
                for (int n = 0; n < 2; ++n) acc[a][b][m][n] = (f32x4){0.f, 0.f, 0.f, 0.f};
    bf16x8 At[4][2], B0[2][2], B1[2][2], Sf[2];
    f32x4 accs[2] = {(f32x4){0.f, 0.f, 0.f, 0.f}, (f32x4){0.f, 0.f, 0.f, 0.f}};
    const char* cA = (const char*)g.A + (size_t)cur.pm * tstep + Epi::k0(cur.seg) * 2; const char* cB = (const char*)g.Bt + (size_t)cur.pn * tstep + Epi::k0(cur.seg) * 2;
    int nt = Epi::nt(cur.seg, K);
    const size_t sstep = (size_t)16 * K * 2;
    const char* cS = (const char*)g.A + (size_t)S.srow0 * K * 2 + (size_t)cur.pm * sstep + Epi::k0(cur.seg) * 2;
    S.a_ready(cur);
    if constexpr (SP2) {
        PG8_STAGE(PG8_SB(0, 0), cB, voffB); PG8_STAGE(PG8_SB(0, 1), cB + hstep, voffB); PG8_STAGE(PG8_SA(0, 0), cA, voffA); PG8_STAGE(PG8_SA(0, 1), cA + hstep, voffA); PG8_STAGE_S(0, cS);
        if (wr == 1) PG8_BAR;
        if constexpr (SLIVER) PG8_WAIT_V(3); else PG8_WAIT_V(2);
        PG8_BAR;
        PG8_STAGE(PG8_SB(1, 0), cB + kstep, voffB); PG8_STAGE(PG8_SA(1, 0), cA + kstep, voffA); PG8_STAGE(PG8_SB(1, 1), cB + hstep + kstep, voffB);
        PG8_WAIT_V(6); PG8_BAR;
    } else {
        PG8_STAGE(PG8_SB(0, 0), cB, voffB); PG8_STAGE(PG8_SA(0, 0), cA, voffA); PG8_STAGE(PG8_SB(0, 1), cB + hstep, voffB); PG8_STAGE(PG8_SA(0, 1), cA + hstep, voffA);
        if (wr == 1) PG8_BAR;
        PG8_WAIT_V(4); PG8_BAR;
        PG8_STAGE(PG8_SB(1, 0), cB + kstep, voffB); PG8_STAGE(PG8_SA(1, 0), cA + kstep, voffA); PG8_STAGE(PG8_SB(1, 1), cB + hstep + kstep, voffB);
        PG8_WAIT_V(6); PG8_BAR;
    }
    for (;;) {
        const bool has_next = S.next(ui + 1, nxt);
        const char* nA = has_next ? (const char*)g.A + (size_t)nxt.pm * tstep + Epi::k0(nxt.seg) * 2 : cA; const char* nB = has_next ? (const char*)g.Bt + (size_t)nxt.pn * tstep + Epi::k0(nxt.seg) * 2 : cB;
        const char* nS = has_next ? (const char*)g.A + (size_t)S.srow0 * K * 2 + (size_t)nxt.pm * sstep + Epi::k0(nxt.seg) * 2 : cS;
        for (int t = 0; t < nt; t += 2) {
            const bool last = (t == nt - 2);
            const char* a1 = cA + (size_t)(t + 1) * kstep;
            const char* a2 = last ? nA : cA + (size_t)(t + 2) * kstep; const char* b2 = last ? nB : cB + (size_t)(t + 2) * kstep;
            const char* a3 = a2 + kstep; const char* b3 = b2 + kstep;
            const char* s1 = cS + (size_t)(t + 1) * kstep; const char* s2 = last ? nS : cS + (size_t)(t + 2) * kstep;
            if (last && has_next) S.a_ready(nxt);
            if constexpr (SP2) {
            PG8_LDB(B0, 0, 0); PG8_LDB(B1, 0, 1); PG8_SCHED; PG8_LDA(At, 0, 0); PG8_STAGE(PG8_SA(1, 1), a1 + hstep, voffA); PG8_STAGE_S(1, s1);
            PG8_WAIT_V89(); PG8_WAIT_L(0); PG8_BAR; PG8_MMA(0, 0, At, B0); PG8_MMA(0, 1, At, B1); PG8_BAR; PG8_SCHED;
            PG8_LDA(At, 0, 1); PG8_LDS_S(0); PG8_STAGE(PG8_SB(0, 0), b2, voffB); PG8_STAGE(PG8_SB(0, 1), b2 + hstep, voffB); PG8_STAGE(PG8_SA(0, 0), a2, voffA);
            PG8_WAIT_V89(); PG8_WAIT_L(0); PG8_BAR; PG8_MMA(1, 0, At, B0); PG8_MMA(1, 1, At, B1); PG8_MMA_S(); PG8_BAR; PG8_SCHED;
            PG8_LDB(B0, 1, 0); PG8_LDB(B1, 1, 1); PG8_SCHED; PG8_LDA(At, 1, 0); PG8_STAGE(PG8_SA(0, 1), a2 + hstep, voffA); PG8_STAGE_S(0, s2);
            PG8_WAIT_V89(); PG8_WAIT_L(0); PG8_BAR; PG8_MMA(0, 0, At, B0); PG8_MMA(0, 1, At, B1); PG8_BAR; PG8_SCHED;
            PG8_LDA(At, 1, 1); PG8_LDS_S(1); PG8_STAGE(PG8_SB(1, 0), b3, voffB); PG8_STAGE(PG8_SB(1, 1), b3 + hstep, voffB); PG8_STAGE(PG8_SA(1, 0), a3, voffA);
            PG8_WAIT_V89(); PG8_WAIT_L(0); PG8_BAR; PG8_MMA(1, 0, At, B0); PG8_MMA(1, 1, At, B1); PG8_MMA_S(); PG8_BAR; PG8_SCHED;
            } else {
            PG8_LDB(B0, 0, 0); PG8_SCHED; PG8_LDA(At, 0, 0); PG8_STAGE(PG8_SA(1, 1), a1 + hstep, voffA);
            PG8_WAIT_L(8); PG8_BAR; PG8_WAIT_L(0); PG8_MMA(0, 0, At, B0); PG8_BAR; PG8_SCHED;
            PG8_LDB(B1, 0, 1); PG8_STAGE(PG8_SB(0, 0), b2, voffB);
            PG8_BAR; PG8_WAIT_L(0); PG8_MMA(0, 1, At, B1); PG8_BAR;
            PG8_LDA(At, 0, 1); PG8_STAGE(PG8_SA(0, 0), a2, voffA);
            PG8_BAR; PG8_WAIT_L(0); PG8_MMA(1, 0, At, B0); PG8_BAR; PG8_SCHED;
            PG8_STAGE(PG8_SB(0, 1), b2 + hstep, voffB);
            PG8_WAIT_V(6); PG8_BAR; PG8_MMA(1, 1, At, B1); PG8_BAR;
            PG8_LDB(B0, 1, 0); PG8_SCHED; PG8_LDA(At, 1, 0); PG8_STAGE(PG8_SA(0, 1), a2 + hstep, voffA);
            PG8_WAIT_L(8); PG8_BAR; PG8_WAIT_L(0); PG8_MMA(0, 0, At, B0); PG8_BAR; PG8_SCHED;
            PG8_LDB(B1, 1, 1); PG8_STAGE(PG8_SB(1, 0), b3, voffB);
            PG8_BAR; PG8_WAIT_L(0); PG8_MMA(0, 1, At, B1); PG8_BAR;
            PG8_LDA(At, 1, 1); PG8_STAGE(PG8_SA(1, 0), a3, voffA);
            PG8_BAR; PG8_WAIT_L(0); PG8_MMA(1, 0, At, B0); PG8_BAR; PG8_SCHED;
            PG8_STAGE(PG8_SB(1, 1), b3 + hstep, voffB);
            PG8_WAIT_V(6); PG8_BAR; PG8_MMA(1, 1, At, B1); PG8_BAR;
            }
        }
        if constexpr (ALIGN_EPI) { if (wr == 0) PG8_BAR; }
        const bool fin = Epi::final_seg(cur.seg);
        if constexpr (!Epi::AFTER_DRAIN) { int l2_ = threadIdx.x; asm volatile("" : "+v"(l2_)); const int fr2 = l2_ & 15, fq2 = (l2_ >> 4) & 3;
            if (fin) { E(acc, cur, wr, wc, fr2, fq2); if constexpr (SLIVER) E.sliver(accs, cur, S.srow0, wr, wc, fr2, fq2); E.finish(cur, S.srow0, l2_); } else { E.mid(acc, cur, wr, wc, fr2, fq2); if constexpr (SLIVER) E.sliver_mid(accs, cur, S.srow0, wr, wc, fr2, fq2); } S.done(cur); }
        if (!has_next) break;
        if (fin) {
#pragma unroll
        for (int a = 0; a < 2; ++a)
#pragma unroll
            for (int b = 0; b < 2; ++b)
#pragma unroll
                for (int m = 0; m < 4; ++m)
#pragma unroll
                    for (int n = 0; n < 2; ++n) acc[a][b][m][n] = (f32x4){0.f, 0.f, 0.f, 0.f};
        accs[0] = (f32x4){0.f, 0.f, 0.f, 0.f}; accs[1] = (f32x4){0.f, 0.f, 0.f, 0.f};
        }
        cur = nxt; cA = nA; cB = nB; cS = nS; nt = Epi::nt(cur.seg, K); ++ui;
        if constexpr (ALIGN_EPI) { if (wr == 1) PG8_BAR; }
    }
    PG8_WAIT_V(0);
    if constexpr (!ALIGN_EPI) { if (wr == 0) PG8_BAR; }
    PG8_BAR;
    if constexpr (Epi::AFTER_DRAIN) { E.fused(acc, cur, wr, wc, fr, fq, lds, wid, lane); S.done(cur); }
#undef PG8_SA
#undef PG8_SB
#undef PG8_STAGE
#undef PG8_LDA
#undef PG8_LDB
#undef PG8_MMA
#undef PG8_WAIT_V
#undef PG8_WAIT_V89
#undef PG8_STAGE_S
#undef PG8_LDS_S
#undef PG8_MMA_S
#undef PG8_WAIT_L
#undef PG8_BAR
#undef PG8_SCHED
}
}
namespace att {
using bf16x8 = __attribute__((ext_vector_type(8))) short;
using s16x4  = __attribute__((ext_vector_type(4))) short;
using f32x16 = __attribute__((ext_vector_type(16))) float;
using u32x4  = __attribute__((ext_vector_type(4))) unsigned;
typedef unsigned short bf16_t;
constexpr int D = 128, NW = 8, QBLK = 32, KVBLK = 64, LD = 2048;
#ifndef ATT_SDEPTH
#define ATT_SDEPTH 1
#endif
constexpr int SDEPTH = ATT_SDEPTH;
constexpr float SCALE = 0.088388347648318440f, LOG2E = 1.4426950408889634f, C = SCALE * LOG2E;
constexpr float THR2 = 8.f * LOG2E;
constexpr size_t SHM_V = KVBLK * D * 2, SHM_K = KVBLK * D * 2;
constexpr int OFF_WS = 2 * SHM_V + 2 * SHM_K, OFF_TAB = OFF_WS + NW * 64 * 4, NTAB = 160, OFF_Q = OFF_TAB + NTAB * 4, SHM_ATTN = OFF_Q + NW * 8192;
#define KSWZ(row, colB) ((row) * 256 + ((colB) ^ (((row) & 7) << 4)))
#define SBAR() __builtin_amdgcn_sched_barrier(0)
__device__ __forceinline__ int crow(int r, int hi) { return (r & 3) + 8 * (r >> 2) + 4 * hi; }
__device__ __forceinline__ unsigned cvtpk(float lo, float hi) { unsigned r; asm volatile("v_cvt_pk_bf16_f32 %0, %1, %2" : "=v"(r) : "v"(lo), "v"(hi)); return r; }

struct WaveInfo { int ntw; int qpos; float cfar; };

__device__ __forceinline__ void partialSM(f32x16& p0, f32x16& p1, float& m_reg, float& mn, float& alpha, int t, const WaveInfo& wi, const float* tab, int hi) {
  if (t >= wi.ntw) {
#pragma unroll
    for (int r = 0; r < 16; ++r) { p0[r] = -1e30f; p1[r] = -1e30f; }
  } else {
    const int dbase = 64 * t + 4 * hi - wi.qpos + 91;
    const int dmax = __builtin_amdgcn_readfirstlane(64 * t + 63 - wi.qpos + 91);
    if (dmax <= 0) {
#pragma unroll
      for (int r = 0; r < 16; ++r) { p0[r] = fmaf(p0[r], C, wi.cfar); p1[r] = fmaf(p1[r], C, wi.cfar); }
    } else {
#pragma unroll
      for (int r = 0; r < 16; ++r) { const int i0 = dbase + (r & 3) + 8 * (r >> 2); const int a = i0 < 0 ? 0 : i0, b = i0 + 32 < 0 ? 0 : i0 + 32;
        p0[r] = fmaf(p0[r], C, tab[a]); p1[r] = fmaf(p1[r], C, tab[b]); }
    }
  }
  float pmax = p0[0];
#pragma unroll
  for (int r = 1; r < 16; ++r) pmax = fmaxf(pmax, p0[r]);
#pragma unroll
  for (int r = 0; r < 16; ++r) pmax = fmaxf(pmax, p1[r]);
  { unsigned pm2_ = __float_as_uint(pmax); asm volatile("" : "+v"(pm2_)); auto rr = __builtin_amdgcn_permlane32_swap(__float_as_uint(pmax), pm2_, false, false);
    pmax = fmaxf(__uint_as_float(rr[0]), __uint_as_float(rr[1])); }
  if (__builtin_expect(__all(pmax - m_reg <= THR2), 1)) { mn = m_reg; alpha = 1.f; }
  else { mn = fmaxf(m_reg, pmax); alpha = __builtin_amdgcn_exp2f(m_reg - mn); m_reg = mn; }
#pragma unroll
  for (int r = 0; r < 16; ++r) { p0[r] -= mn; p1[r] -= mn; }
#pragma unroll
  for (int r = 0; r < 16; ++r) p0[r] = __builtin_amdgcn_exp2f(p0[r]);
}
__device__ __forceinline__ void finishSM(f32x16& p0, f32x16& p1, float alpha, float& l_reg, bf16x8& pa0, bf16x8& pa1, bf16x8& pa2, bf16x8& pa3) {
#pragma unroll
  for (int r = 0; r < 16; ++r) p1[r] = __builtin_amdgcn_exp2f(p1[r]);
  float ps = 0;
#pragma unroll
  for (int r = 0; r < 16; ++r) ps += p0[r];
#pragma unroll
  for (int r = 0; r < 16; ++r) ps += p1[r];
  { unsigned ps2_ = __float_as_uint(ps); asm volatile("" : "+v"(ps2_)); auto rr = __builtin_amdgcn_permlane32_swap(__float_as_uint(ps), ps2_, false, false);
    ps = __uint_as_float(rr[0]) + __uint_as_float(rr[1]); }
  l_reg = l_reg * alpha + ps;
#define PK4(P, BASE, OUT) do { unsigned a0 = cvtpk(P[BASE + 0], P[BASE + 1]), a1 = cvtpk(P[BASE + 2], P[BASE + 3]);   \
    unsigned b0 = cvtpk(P[BASE + 4], P[BASE + 5]), b1 = cvtpk(P[BASE + 6], P[BASE + 7]);                              \
    auto r0 = __builtin_amdgcn_permlane32_swap(a0, b0, false, false); auto r1 = __builtin_amdgcn_permlane32_swap(a1, b1, false, false); \
    u32x4 w = {r0[0], r1[0], r0[1], r1[1]}; OUT = *reinterpret_cast<bf16x8*>(&w); } while (0)
  PK4(p0, 0, pa0); PK4(p0, 8, pa1); PK4(p1, 0, pa2); PK4(p1, 8, pa3);
#undef PK4
}
__device__ __forceinline__ void qkt(f32x16& p0, f32x16& p1, const bf16_t* Ks, const char* qf, int r32, int hi) {
  p0 = f32x16{}; p1 = f32x16{};
#pragma unroll
  for (int d0 = 0; d0 < 8; ++d0) { int cb = (d0 * 16 + hi * 8) * 2;
    bf16x8 b0 = *reinterpret_cast<const bf16x8*>((const char*)Ks + KSWZ(r32, cb));
    bf16x8 b1 = *reinterpret_cast<const bf16x8*>((const char*)Ks + KSWZ(32 + r32, cb));
    bf16x8 q = *reinterpret_cast<const bf16x8*>(qf + d0 * 1024);
    p0 = __builtin_amdgcn_mfma_f32_32x32x16_bf16(b0, q, p0, 0, 0, 0);
    p1 = __builtin_amdgcn_mfma_f32_32x32x16_bf16(b1, q, p1, 0, 0, 0); }
}
__device__ __forceinline__ int v_st(int k, int c) { const int kk = (k & ~0xC) | ((k & 4) << 1) | ((k & 8) >> 1); return ((kk >> 3) * 4 + (c >> 5)) * 512 + ((kk & 7) * 32 + (c & 31)) * 2; }
__device__ __forceinline__ int v_rd_base(int lane) { return ((lane & 3) << 3) | (((lane >> 2) & 3) << 6) | (((lane >> 4) & 1) << 5) | (((lane >> 5) & 1) << 8); }
constexpr int v_rd_off(int d0, int ks, int half) { return d0 * 512 + ks * 4096 + half * 2048; }
template <int OFF> __device__ __forceinline__ s16x4 tr_read(int vb) {
  s16x4 r; asm volatile("ds_read_b64_tr_b16 %0, %1 offset:%2" : "=&v"(r) : "v"(vb), "i"(OFF) : "memory"); return r;
}
template <int D0> __device__ __forceinline__ void pv_one(f32x16& od, int vb, bf16x8 pa0, bf16x8 pa1, bf16x8 pa2, bf16x8 pa3) {
  const s16x4 l0 = tr_read<v_rd_off(D0, 0, 0)>(vb), h0 = tr_read<v_rd_off(D0, 0, 1)>(vb), l1 = tr_read<v_rd_off(D0, 1, 0)>(vb), h1 = tr_read<v_rd_off(D0, 1, 1)>(vb);
  const s16x4 l2 = tr_read<v_rd_off(D0, 2, 0)>(vb), h2 = tr_read<v_rd_off(D0, 2, 1)>(vb), l3 = tr_read<v_rd_off(D0, 3, 0)>(vb), h3 = tr_read<v_rd_off(D0, 3, 1)>(vb);
  asm volatile("s_waitcnt lgkmcnt(0)" ::: "memory"); SBAR();
#define PK(L, H) (bf16x8){L[0], L[1], L[2], L[3], H[0], H[1], H[2], H[3]}
  od = __builtin_amdgcn_mfma_f32_32x32x16_bf16(pa0, PK(l0, h0), od, 0, 0, 0);
  od = __builtin_amdgcn_mfma_f32_32x32x16_bf16(pa1, PK(l1, h1), od, 0, 0, 0);
  od = __builtin_amdgcn_mfma_f32_32x32x16_bf16(pa2, PK(l2, h2), od, 0, 0, 0);
  od = __builtin_amdgcn_mfma_f32_32x32x16_bf16(pa3, PK(l3, h3), od, 0, 0, 0);
#undef PK
}
__device__ __forceinline__ void pv_d0(f32x16* o, int vb, bf16x8 pa0, bf16x8 pa1, bf16x8 pa2, bf16x8 pa3) {
  pv_one<0>(o[0], vb, pa0, pa1, pa2, pa3); pv_one<1>(o[1], vb, pa0, pa1, pa2, pa3); pv_one<2>(o[2], vb, pa0, pa1, pa2, pa3); pv_one<3>(o[3], vb, pa0, pa1, pa2, pa3);
}
__device__ __forceinline__ void attn_unit(const bf16_t* __restrict__ Qb, const bf16_t* __restrict__ Kh, const bf16_t* __restrict__ Vh, bf16_t* __restrict__ Ob,
                                          int NT, int ntw, int qpos0, int nvalid, char* lds) {
  int tid_ = threadIdx.x; asm volatile("" : "+v"(tid_));
  const int tid = tid_, wid = tid >> 6, lane = tid & 63, r32 = lane & 31, hi = lane >> 5;
  bf16_t* V_lds = (bf16_t*)lds; bf16_t* K_lds = (bf16_t*)(lds + 2 * SHM_V);
  float* ws = (float*)(lds + OFF_WS) + wid * 64; float* li_l = ws; float* al_l = ws + 32;
  const float* tab = (const float*)(lds + OFF_TAB);
  float m_reg = -1e30f, l_reg = 0; f32x16 o[4] = {};
  char* qf = lds + OFF_Q + wid * 8192 + (hi * 32 + r32) * 16;
  const bf16_t* Qw = Qb + (long)(wid * QBLK + r32) * LD + hi * 8;
#pragma unroll
  for (int d0 = 0; d0 < 8; ++d0) *reinterpret_cast<bf16x8*>(qf + d0 * 1024) = *reinterpret_cast<const bf16x8*>(Qw + d0 * 16);
  const int sr = tid >> 4, sc = (tid & 15) * 8, vst0 = v_st(sr, sc), vst1 = v_st(32 + sr, sc);
  const int vb0 = (int)(uintptr_t)V_lds + v_rd_base(lane);
  struct { bf16x8 vs0, vs1, ks0, ks1; } sr_[SDEPTH];
#define SLOAD(i, k0) do { sr_[i].vs0 = *reinterpret_cast<const bf16x8*>(&Vh[(long)((k0) + sr) * LD + sc]); sr_[i].vs1 = *reinterpret_cast<const bf16x8*>(&Vh[(long)((k0) + 32 + sr) * LD + sc]); \
    sr_[i].ks0 = *reinterpret_cast<const bf16x8*>(&Kh[(long)((k0) + sr) * LD + sc]); sr_[i].ks1 = *reinterpret_cast<const bf16x8*>(&Kh[(long)((k0) + 32 + sr) * LD + sc]); } while (0)
#define SWRITE(b, i) do { *(bf16x8*)((char*)V_lds + (b) * SHM_V + vst0) = sr_[i].vs0;          \
    *(bf16x8*)((char*)V_lds + (b) * SHM_V + vst1) = sr_[i].vs1; int kc = sc * 2;               \
    *(bf16x8*)((char*)K_lds + (b) * SHM_K + KSWZ(sr, kc)) = sr_[i].ks0;                       \
    *(bf16x8*)((char*)K_lds + (b) * SHM_K + KSWZ(32 + sr, kc)) = sr_[i].ks1; } while (0)
#define SWAIT() do { if constexpr (SDEPTH == 2) asm volatile("s_waitcnt vmcnt(4)" ::: "memory"); else asm volatile("s_waitcnt vmcnt(0)" ::: "memory"); } while (0)
#define RESC(a) do { if (__any((a) < 1.f)) { if (hi == 0) al_l[r32] = (a); asm volatile("s_waitcnt lgkmcnt(0)" ::: "memory"); \
    _Pragma("unroll") for (int d = 0; d < 4; ++d) _Pragma("unroll") for (int r = 0; r < 16; ++r) o[d][r] *= al_l[crow(r, hi)]; } } while (0)
  f32x16 pA0 = {}, pA1 = {}, pB0 = {}, pB1 = {}; float mnA = 0.f, mnB = 0.f, alA = 1.f, alB = 1.f; bf16x8 pa0 = {}, pa1 = {}, pa2 = {}, pa3 = {};
  const bool act = __builtin_amdgcn_readfirstlane(wid * QBLK) < nvalid;
  WaveInfo wi; wi.ntw = ntw; wi.qpos = qpos0 + wid * QBLK + r32; wi.cfar = 0.f;
  constexpr int SE = 0, SO = SDEPTH - 1;
  SLOAD(SE, 0); asm volatile("s_waitcnt vmcnt(0)" ::: "memory"); SWRITE(0, SE); __syncthreads();
  wi.cfar = tab[0];
  if (act) { qkt(pA0, pA1, K_lds, qf, r32, hi); partialSM(pA0, pA1, m_reg, mnA, alA, 0, wi, tab, hi); }
  SLOAD(SO, KVBLK); if constexpr (SDEPTH == 2) { if (2 < NT) SLOAD(SE, 2 * KVBLK); }
  SWAIT(); SWRITE(1, SO); __syncthreads();
  for (int j = 1; j + 1 < NT; j += 2) {
    SBAR(); if (act) { qkt(pB0, pB1, (bf16_t*)((char*)K_lds + SHM_K), qf, r32, hi);
    finishSM(pA0, pA1, alA, l_reg, pa0, pa1, pa2, pa3); } SBAR();
    SLOAD(SO, (j + SDEPTH) * KVBLK); SBAR();
    if (act) { pv_d0(o, vb0, pa0, pa1, pa2, pa3); partialSM(pB0, pB1, m_reg, mnB, alB, j, wi, tab, hi); }
    __syncthreads(); SWAIT(); SWRITE(0, SE);
    if (act) { RESC(alB); } __syncthreads();
    SBAR(); if (act) { qkt(pA0, pA1, K_lds, qf, r32, hi);
    finishSM(pB0, pB1, alB, l_reg, pa0, pa1, pa2, pa3); } SBAR();
    if (SDEPTH == 1 || j + 3 < NT) SLOAD(SE, (j + 1 + SDEPTH) * KVBLK); SBAR();
    if (act) { pv_d0(o, vb0 + (int)SHM_V, pa0, pa1, pa2, pa3); partialSM(pA0, pA1, m_reg, mnA, alA, j + 1, wi, tab, hi); }
    __syncthreads(); SWAIT(); SWRITE(1, SO);
    if (act) { RESC(alA); } __syncthreads();
  }
  SBAR(); if (act) { qkt(pB0, pB1, (bf16_t*)((char*)K_lds + SHM_K), qf, r32, hi);
  finishSM(pA0, pA1, alA, l_reg, pa0, pa1, pa2, pa3); } SBAR();
  if (act) { pv_d0(o, vb0, pa0, pa1, pa2, pa3); partialSM(pB0, pB1, m_reg, mnB, alB, NT - 1, wi, tab, hi); }
  __syncthreads();
  if (act) { RESC(alB);
  finishSM(pB0, pB1, alB, l_reg, pa0, pa1, pa2, pa3); SBAR();
  pv_d0(o, vb0 + (int)SHM_V, pa0, pa1, pa2, pa3); }
  if (hi == 0) li_l[r32] = l_reg; asm volatile("s_waitcnt lgkmcnt(0)" ::: "memory");
  if (act) {
    float rli[16];
#pragma unroll
    for (int r = 0; r < 16; ++r) rli[r] = __builtin_amdgcn_rcpf(li_l[crow(r, hi)]);
    bf16_t* st = (bf16_t*)(lds + OFF_Q + wid * 8192);
#pragma unroll
    for (int r = 0; r < 16; ++r) { const int orow = crow(r, hi);
#pragma unroll
      for (int d0 = 0; d0 < 4; ++d0) { const float v = o[d0][r] * rli[r]; unsigned u = __float_as_uint(v); u = (u + 0x7fffu + ((u >> 16) & 1u)) >> 16; st[orow * 128 + d0 * 32 + r32] = (bf16_t)u; } }
    asm volatile("s_waitcnt lgkmcnt(0)" ::: "memory");
    bf16_t* Ow = Ob + (long)(wid * QBLK) * LD;
#pragma unroll
    for (int i = 0; i < 4; ++i) { const int row = i * 8 + (lane >> 3), ch = lane & 7; const u32x4 v = *(const u32x4*)(st + row * 128 + ch * 8); (void)ch;
      const u32x4 v2 = *(const u32x4*)(st + row * 128 + 64 + ch * 8);
      *(u32x4*)(Ow + (long)row * LD + ch * 8) = v; *(u32x4*)(Ow + (long)row * LD + 64 + ch * 8) = v2; }
  }
  __syncthreads();
#undef SLOAD
#undef SWRITE
#undef SWAIT
#undef RESC
}
#undef KSWZ
#undef SBAR
}
namespace att2 {
using att::bf16x8; using att::s16x4; using att::f32x16; using att::u32x4; using att::bf16_t; using att::WaveInfo; using att::crow; using att::cvtpk;
constexpr int D = 128, NW = 8, QBLK = 32, KVBLK = 64, LD = 2048;
constexpr float C = att::C, THR2 = att::THR2;
constexpr int SHM_V = KVBLK * 256 * 2, SHM_K = KVBLK * D * 2;
constexpr int QW = 7168;
constexpr int OFF_K = 2 * SHM_V, OFF_WS = OFF_K + 2 * SHM_K, OFF_TAB = OFF_WS + NW * 64 * 4, NTAB = 160, OFF_Q = OFF_TAB + NTAB * 4, SHM_ATTN = OFF_Q + NW * QW;
static_assert(SHM_ATTN <= 162816, "attention LDS image fits below the workgroup's control words");
static_assert(OFF_Q % 16 == 0, "Q fragments 16-byte aligned");
#define KSWZ(row, colB) ((row) * 256 + ((colB) ^ (((row) & 7) << 4)))
#define SBAR() __builtin_amdgcn_sched_barrier(0)
#define LAS_ __attribute__((address_space(3)))
__device__ __forceinline__ void smax(f32x16& p0, f32x16& p1, float& m_reg, float& l_reg, float& alpha, int t, const WaveInfo& wi, const float* tab, int hi,
                                     bf16x8& pa0, bf16x8& pa1, bf16x8& pa2, bf16x8& pa3) {
  if (t >= wi.ntw) {
#pragma unroll
    for (int r = 0; r < 16; ++r) { p0[r] = -1e30f; p1[r] = -1e30f; }
  } else {
    const int dbase = 64 * t + 4 * hi - wi.qpos + 91;
    const int dmax = __builtin_amdgcn_readfirstlane(64 * t + 63 - wi.qpos + 91);
    if (dmax <= 0) {
#pragma unroll
      for (int r = 0; r < 16; ++r) { p0[r] = fmaf(p0[r], C, wi.cfar); p1[r] = fmaf(p1[r], C, wi.cfar); }
    } else {
#pragma unroll
      for (int r = 0; r < 16; ++r) { const int i0 = dbase + (r & 3) + 8 * (r >> 2); const int a = i0 < 0 ? 0 : i0, b = i0 + 32 < 0 ? 0 : i0 + 32;
        p0[r] = fmaf(p0[r], C, tab[a]); p1[r] = fmaf(p1[r], C, tab[b]); }
    }
  }
  float pmax = p0[0];
#pragma unroll
  for (int r = 1; r < 16; ++r) pmax = fmaxf(pmax, p0[r]);
#pragma unroll
  for (int r = 0; r < 16; ++r) pmax = fmaxf(pmax, p1[r]);
  { unsigned pm2_ = __float_as_uint(pmax); asm volatile("" : "+v"(pm2_)); auto rr = __builtin_amdgcn_permlane32_swap(__float_as_uint(pmax), pm2_, false, false);
    pmax = fmaxf(__uint_as_float(rr[0]), __uint_as_float(rr[1])); }
  float mn;
  if (__builtin_expect(__all(pmax - m_reg <= THR2), 1)) { mn = m_reg; alpha = 1.f; }
  else { mn = fmaxf(m_reg, pmax); alpha = __builtin_amdgcn_exp2f(m_reg - mn); m_reg = mn; }
#pragma unroll
  for (int r = 0; r < 16; ++r) { p0[r] = __builtin_amdgcn_exp2f(p0[r] - mn); p1[r] = __builtin_amdgcn_exp2f(p1[r] - mn); }
  float ps = 0;
#pragma unroll
  for (int r = 0; r < 16; ++r) ps += p0[r];
#pragma unroll
  for (int r = 0; r < 16; ++r) ps += p1[r];
  { unsigned ps2_ = __float_as_uint(ps); asm volatile("" : "+v"(ps2_)); auto rr = __builtin_amdgcn_permlane32_swap(__float_as_uint(ps), ps2_, false, false);
    ps = __uint_as_float(rr[0]) + __uint_as_float(rr[1]); }
  l_reg = l_reg * alpha + ps;
#define PK4(P, BASE, OUT) do { unsigned a0 = cvtpk(P[BASE + 0], P[BASE + 1]), a1 = cvtpk(P[BASE + 2], P[BASE + 3]);   \
    unsigned b0 = cvtpk(P[BASE + 4], P[BASE + 5]), b1 = cvtpk(P[BASE + 6], P[BASE + 7]);                              \
    auto r0 = __builtin_amdgcn_permlane32_swap(a0, b0, false, false); auto r1 = __builtin_amdgcn_permlane32_swap(a1, b1, false, false); \
    u32x4 w = {r0[0], r1[0], r0[1], r1[1]}; OUT = *reinterpret_cast<bf16x8*>(&w); } while (0)
  PK4(p0, 0, pa0); PK4(p0, 8, pa1); PK4(p1, 0, pa2); PK4(p1, 8, pa3);
#undef PK4
}
__device__ __forceinline__ int v_st(int k, int c) { const int kk = (k & ~0xC) | ((k & 4) << 1) | ((k & 8) >> 1); return ((kk >> 3) * 8 + (c >> 5)) * 512 + ((kk & 7) * 32 + (c & 31)) * 2; }
constexpr int v_rd_off(int d0, int ks, int half) { return d0 * 512 + ks * 8192 + half * 4096; }
template <int OFF> __device__ __forceinline__ s16x4 tr_read(int vb) {
  s16x4 r; asm volatile("ds_read_b64_tr_b16 %0, %1 offset:%2" : "=&v"(r) : "v"(vb), "i"(OFF) : "memory"); return r;
}
template <int D0> __device__ __forceinline__ void vload(s16x4 (&l)[4], s16x4 (&h)[4], int vb) {
  l[0] = tr_read<v_rd_off(D0, 0, 0)>(vb); h[0] = tr_read<v_rd_off(D0, 0, 1)>(vb); l[1] = tr_read<v_rd_off(D0, 1, 0)>(vb); h[1] = tr_read<v_rd_off(D0, 1, 1)>(vb);
  l[2] = tr_read<v_rd_off(D0, 2, 0)>(vb); h[2] = tr_read<v_rd_off(D0, 2, 1)>(vb); l[3] = tr_read<v_rd_off(D0, 3, 0)>(vb); h[3] = tr_read<v_rd_off(D0, 3, 1)>(vb);
}
__device__ __forceinline__ void vmma(f32x16& od, const s16x4 (&l)[4], const s16x4 (&h)[4], bf16x8 pa0, bf16x8 pa1, bf16x8 pa2, bf16x8 pa3) {
#define PK(L, H) (bf16x8){L[0], L[1], L[2], L[3], H[0], H[1], H[2], H[3]}
  od = __builtin_amdgcn_mfma_f32_32x32x16_bf16(pa0, PK(l[0], h[0]), od, 0, 0, 0);
  od = __builtin_amdgcn_mfma_f32_32x32x16_bf16(pa1, PK(l[1], h[1]), od, 0, 0, 0);
  od = __builtin_amdgcn_mfma_f32_32x32x16_bf16(pa2, PK(l[2], h[2]), od, 0, 0, 0);
  od = __builtin_amdgcn_mfma_f32_32x32x16_bf16(pa3, PK(l[3], h[3]), od, 0, 0, 0);
#undef PK
}
__device__ __forceinline__ void pv_all(f32x16* o, int vb, bf16x8 pa0, bf16x8 pa1, bf16x8 pa2, bf16x8 pa3) {
  s16x4 la[4], ha[4], lb[4], hb[4];
#define WAIT8() do { asm volatile("s_waitcnt lgkmcnt(8)" ::: "memory"); SBAR(); } while (0)
  vload<0>(la, ha, vb);
  vload<1>(lb, hb, vb); WAIT8(); vmma(o[0], la, ha, pa0, pa1, pa2, pa3); SBAR();
  vload<2>(la, ha, vb); WAIT8(); vmma(o[1], lb, hb, pa0, pa1, pa2, pa3); SBAR();
  vload<3>(lb, hb, vb); WAIT8(); vmma(o[2], la, ha, pa0, pa1, pa2, pa3); SBAR();
  vload<4>(la, ha, vb); WAIT8(); vmma(o[3], lb, hb, pa0, pa1, pa2, pa3); SBAR();
  vload<5>(lb, hb, vb); WAIT8(); vmma(o[4], la, ha, pa0, pa1, pa2, pa3); SBAR();
  vload<6>(la, ha, vb); WAIT8(); vmma(o[5], lb, hb, pa0, pa1, pa2, pa3); SBAR();
  vload<7>(lb, hb, vb); WAIT8(); vmma(o[6], la, ha, pa0, pa1, pa2, pa3); SBAR();
  asm volatile("s_waitcnt lgkmcnt(0)" ::: "memory"); SBAR(); vmma(o[7], lb, hb, pa0, pa1, pa2, pa3);
#undef WAIT8
}
__device__ __forceinline__ unsigned cvtpk_t(float lo, float hi) { unsigned r; asm volatile("s_nop 1\n\tv_cvt_pk_bf16_f32 %0, %1, %2" : "=v"(r) : "v"(lo), "v"(hi)); return r; }
#define PK4T(P, BASE, OUT) do { unsigned a0 = cvtpk_t(P[BASE + 0], P[BASE + 1]), a1 = cvtpk_t(P[BASE + 2], P[BASE + 3]);   \
    unsigned b0 = cvtpk_t(P[BASE + 4], P[BASE + 5]), b1 = cvtpk_t(P[BASE + 6], P[BASE + 7]);                              \
    auto r0 = __builtin_amdgcn_permlane32_swap(a0, b0, false, false); auto r1 = __builtin_amdgcn_permlane32_swap(a1, b1, false, false); \
    u32x4 w = {r0[0], r1[0], r0[1], r1[1]}; OUT = *reinterpret_cast<bf16x8*>(&w); } while (0)
__device__ __forceinline__ void smax1(f32x16& p0, f32x16& p1, float& m_reg, float& alpha, float& mn_out, int t, const WaveInfo& wi, const float* tab, int hi, bf16x8& pa0, bf16x8& pa1) {
  if (t >= wi.ntw) {
#pragma unroll
    for (int r = 0; r < 16; ++r) { p0[r] = -1e30f; p1[r] = -1e30f; }
  } else {
    const int dbase = 64 * t + 4 * hi - wi.qpos + 91;
    const int dmax = __builtin_amdgcn_readfirstlane(64 * t + 63 - wi.qpos + 91);
    if (dmax <= 0) {
#pragma unroll
      for (int r = 0; r < 16; ++r) { p0[r] = fmaf(p0[r], C, wi.cfar); p1[r] = fmaf(p1[r], C, wi.cfar); }
    } else {
#pragma unroll
      for (int r = 0; r < 16; ++r) { const int i0 = dbase + (r & 3) + 8 * (r >> 2); const int a = i0 < 0 ? 0 : i0, b = i0 + 32 < 0 ? 0 : i0 + 32;
        p0[r] = fmaf(p0[r], C, tab[a]); p1[r] = fmaf(p1[r], C, tab[b]); }
    }
  }
  float pmax = p0[0];
#pragma unroll
  for (int r = 1; r < 16; ++r) pmax = fmaxf(pmax, p0[r]);
#pragma unroll
  for (int r = 0; r < 16; ++r) pmax = fmaxf(pmax, p1[r]);
  { unsigned pm2_ = __float_as_uint(pmax); asm volatile("" : "+v"(pm2_)); auto rr = __builtin_amdgcn_permlane32_swap(__float_as_uint(pmax), pm2_, false, false);
    pmax = fmaxf(__uint_as_float(rr[0]), __uint_as_float(rr[1])); }
  float mn;
  if (__builtin_expect(__all(pmax - m_reg <= THR2), 1)) { mn = m_reg; alpha = 1.f; }
  else { mn = fmaxf(m_reg, pmax); alpha = __builtin_amdgcn_exp2f(m_reg - mn); m_reg = mn; }
  mn_out = mn;
#pragma unroll
  for (int r = 0; r < 16; ++r) p0[r] = __builtin_amdgcn_exp2f(p0[r] - mn);
  PK4T(p0, 0, pa0); PK4T(p0, 8, pa1);
}
template <int D0, int KS0> __device__ __forceinline__ void vload2(s16x4 (&l)[2], s16x4 (&h)[2], int vb) {
  l[0] = tr_read<v_rd_off(D0, KS0, 0)>(vb); h[0] = tr_read<v_rd_off(D0, KS0, 1)>(vb); l[1] = tr_read<v_rd_off(D0, KS0 + 1, 0)>(vb); h[1] = tr_read<v_rd_off(D0, KS0 + 1, 1)>(vb);
}
#define PKV(L, H) (bf16x8){L[0], L[1], L[2], L[3], H[0], H[1], H[2], H[3]}
__device__ __forceinline__ void pv_split(f32x16* o, int vb, bf16x8 pa0, bf16x8 pa1, const f32x16& p0, f32x16& p1, float mn, float& l_reg, float alpha) {
  s16x4 la[2], ha[2], lb[2], hb[2]; float ps = 0.f; bf16x8 pa2, pa3;
#define WAIT4() do { asm volatile("s_waitcnt lgkmcnt(4)" ::: "memory"); SBAR(); } while (0)
#define WAIT0() do { asm volatile("s_waitcnt lgkmcnt(0)" ::: "memory"); SBAR(); } while (0)
#define STEP_A(D, L_, H_, EXTRA) do { o[D] = __builtin_amdgcn_mfma_f32_32x32x16_bf16(pa0, PKV(L_[0], H_[0]), o[D], 0, 0, 0); p1[2 * (D)] = __builtin_amdgcn_exp2f(p1[2 * (D)] - mn); ps += p0[2 * (D)]; \
    o[D] = __builtin_amdgcn_mfma_f32_32x32x16_bf16(pa1, PKV(L_[1], H_[1]), o[D], 0, 0, 0); p1[2 * (D) + 1] = __builtin_amdgcn_exp2f(p1[2 * (D) + 1] - mn); ps += p0[2 * (D) + 1]; EXTRA; SBAR(); } while (0)
#define STEP_B(D, L_, H_, EXTRA) do { o[D] = __builtin_amdgcn_mfma_f32_32x32x16_bf16(pa2, PKV(L_[0], H_[0]), o[D], 0, 0, 0); EXTRA; ps += p1[2 * (D)]; \
    o[D] = __builtin_amdgcn_mfma_f32_32x32x16_bf16(pa3, PKV(L_[1], H_[1]), o[D], 0, 0, 0); ps += p1[2 * (D) + 1]; SBAR(); } while (0)
  vload2<0, 0>(la, ha, vb);
  unsigned c0, c1, c2, c3;
#define SWZ(OUT) do { auto r0 = __builtin_amdgcn_permlane32_swap(c0, c2, false, false); auto r1 = __builtin_amdgcn_permlane32_swap(c1, c3, false, false); u32x4 w = {r0[0], r1[0], r0[1], r1[1]}; OUT = *reinterpret_cast<bf16x8*>(&w); } while (0)
  vload2<1, 0>(lb, hb, vb); WAIT4(); STEP_A(0, la, ha, (void)0);
  vload2<2, 0>(la, ha, vb); WAIT4(); STEP_A(1, lb, hb, (void)0);
  vload2<3, 0>(lb, hb, vb); WAIT4(); STEP_A(2, la, ha, (void)0);
  vload2<4, 0>(la, ha, vb); WAIT4(); STEP_A(3, lb, hb, (void)0);
  vload2<5, 0>(lb, hb, vb); WAIT4(); STEP_A(4, la, ha, (c0 = cvtpk_t(p1[0], p1[1]), c1 = cvtpk_t(p1[2], p1[3])));
  vload2<6, 0>(la, ha, vb); WAIT4(); STEP_A(5, lb, hb, (c2 = cvtpk_t(p1[4], p1[5]), c3 = cvtpk_t(p1[6], p1[7])));
  vload2<7, 0>(lb, hb, vb); WAIT4(); STEP_A(6, la, ha, SWZ(pa2));
  vload2<0, 2>(la, ha, vb); WAIT4(); STEP_A(7, lb, hb, (void)0);
  vload2<1, 2>(lb, hb, vb); WAIT4(); STEP_B(0, la, ha, do { c0 = cvtpk_t(p1[8], p1[9]); c1 = cvtpk_t(p1[10], p1[11]); c2 = cvtpk_t(p1[12], p1[13]); c3 = cvtpk_t(p1[14], p1[15]); SWZ(pa3); } while (0));
  vload2<2, 2>(la, ha, vb); WAIT4(); STEP_B(1, lb, hb, (void)0);
  vload2<3, 2>(lb, hb, vb); WAIT4(); STEP_B(2, la, ha, (void)0);
  vload2<4, 2>(la, ha, vb); WAIT4(); STEP_B(3, lb, hb, (void)0);
  vload2<5, 2>(lb, hb, vb); WAIT4(); STEP_B(4, la, ha, (void)0);
  vload2<6, 2>(la, ha, vb); WAIT4(); STEP_B(5, lb, hb, (void)0);
  vload2<7, 2>(lb, hb, vb); WAIT4(); STEP_B(6, la, ha, (void)0);
  WAIT0(); STEP_B(7, lb, hb, (void)0);
#undef SWZ
  { unsigned ps2_ = __float_as_uint(ps); asm volatile("" : "+v"(ps2_)); auto rr = __builtin_amdgcn_permlane32_swap(__float_as_uint(ps), ps2_, false, false);
    ps = __uint_as_float(rr[0]) + __uint_as_float(rr[1]); }
  l_reg = l_reg * alpha + ps;
#undef WAIT4
#undef WAIT0
#undef STEP_A
#undef STEP_B
}
#undef PKV
#undef PK4T
__device__ __forceinline__ void qkt2(f32x16& p0, f32x16& p1, const bf16_t* Ks, const char* qf, const bf16x8 q0, int r32, int hi) {
  p0 = f32x16{}; p1 = f32x16{};
#pragma unroll
  for (int d0 = 0; d0 < 8; ++d0) { int cb = (d0 * 16 + hi * 8) * 2;
    bf16x8 b0 = *reinterpret_cast<const bf16x8*>((const char*)Ks + KSWZ(r32, cb));
    bf16x8 b1 = *reinterpret_cast<const bf16x8*>((const char*)Ks + KSWZ(32 + r32, cb));
    bf16x8 q = d0 == 0 ? q0 : *reinterpret_cast<const bf16x8*>(qf + (d0 - 1) * 1024);
    p0 = __builtin_amdgcn_mfma_f32_32x32x16_bf16(b0, q, p0, 0, 0, 0);
    p1 = __builtin_amdgcn_mfma_f32_32x32x16_bf16(b1, q, p1, 0, 0, 0); }
}
__device__ __forceinline__ void attn_unit(const bf16_t* __restrict__ Qb, const bf16_t* __restrict__ Kh, const bf16_t* __restrict__ Vh, bf16_t* __restrict__ Ob,
                                          int NT, int ntw, int qpos0, int nvalid, char* lds) {
  int tid_ = threadIdx.x; asm volatile("" : "+v"(tid_));
  const int tid = tid_, wid = tid >> 6, lane = tid & 63, r32 = lane & 31, hi = lane >> 5;
  bf16_t* V_lds = (bf16_t*)lds; bf16_t* K_lds = (bf16_t*)(lds + OFF_K);
  float* ws = (float*)(lds + OFF_WS) + wid * 64; float* li_l = ws; float* al_l = ws + 32;
  const float* tab = (const float*)(lds + OFF_TAB);
  float m_reg = -1e30f, l_reg = 0; f32x16 o[8] = {};
  char* qf = lds + OFF_Q + wid * QW + (hi * 32 + r32) * 16;
  const bf16_t* Qw = Qb + (long)(wid * QBLK + r32) * LD + hi * 8;
  const bf16x8 q0 = *reinterpret_cast<const bf16x8*>(Qw);
#pragma unroll
  for (int d0 = 1; d0 < 8; ++d0) *reinterpret_cast<bf16x8*>(qf + (d0 - 1) * 1024) = *reinterpret_cast<const bf16x8*>(Qw + d0 * 16);
  const int vb0 = (int)(uintptr_t)V_lds + att::v_rd_base(lane);
  const int wids = __builtin_amdgcn_readfirstlane(wid);
  const int kr0 = lane >> 4, kr1 = 4 + (lane >> 4);
  const bf16_t* ksrc0 = Kh + (long)(8 * wids + kr0) * LD + ((lane & 15) ^ kr0) * 8; const bf16_t* ksrc1 = Kh + (long)(8 * wids + kr1) * LD + ((lane & 15) ^ kr1) * 8;
  LAS_ unsigned char* ldsk = (LAS_ unsigned char*)K_lds + wids * 2048;
#define KDMA(k0, b) do { __builtin_amdgcn_global_load_lds((const unsigned*)(ksrc0 + (long)(k0) * LD), (LAS_ unsigned*)(ldsk + (b) * SHM_K), 16, 0, 0); \
    __builtin_amdgcn_global_load_lds((const unsigned*)(ksrc1 + (long)(k0) * LD), (LAS_ unsigned*)(ldsk + (b) * SHM_K + 1024), 16, 0, 0); } while (0)
  const int vkk = 8 * wids + ((lane & 31) >> 2), vk = (vkk & ~0xC) | ((vkk & 4) << 1) | ((vkk & 8) >> 1);
  const bf16_t* vsrc = Vh + (long)vk * LD + 32 * (lane >> 5) + 8 * (lane & 3);
  LAS_ unsigned char* ldsv = (LAS_ unsigned char*)V_lds + wids * 4096;
#define VDMA(k0, b) do { _Pragma("unroll") for (int i_ = 0; i_ < 4; ++i_) \
    __builtin_amdgcn_global_load_lds((const unsigned*)(vsrc + (long)(k0) * LD + 64 * i_), (LAS_ unsigned*)(ldsv + (b) * SHM_V + i_ * 1024), 16, 0, 0); } while (0)
  const bool act = __builtin_amdgcn_readfirstlane(wid * QBLK) < nvalid;
  WaveInfo wi; wi.ntw = ntw; wi.qpos = qpos0 + wid * QBLK + r32; wi.cfar = 0.f;
  VDMA(0, 0); KDMA(0, 0); asm volatile("s_waitcnt vmcnt(0)" ::: "memory");
  __syncthreads();
  wi.cfar = tab[0];
  for (int j = 0; j < NT; ++j) {
    f32x16 p0, p1; bf16x8 pa0, pa1; float alpha;
    if (j + 1 < NT) { VDMA((j + 1) * KVBLK, (j + 1) & 1); KDMA((j + 1) * KVBLK, (j + 1) & 1); }
    SBAR();
    const bool vis = act && j < ntw;
    if (vis) {
      qkt2(p0, p1, K_lds + (j & 1) * (SHM_K / 2), qf, q0, r32, hi);
      float mn_; smax1(p0, p1, m_reg, alpha, mn_, j, wi, tab, hi, pa0, pa1);
      if (__any(alpha < 1.f)) { if (hi == 0) al_l[r32] = alpha; asm volatile("s_waitcnt lgkmcnt(0)" ::: "memory");
#pragma unroll
        for (int r = 0; r < 16; ++r) { const float a = al_l[crow(r, hi)];
#pragma unroll
          for (int d = 0; d < 8; ++d) o[d][r] *= a; } }
      const int vb = vb0 + (j & 1) * SHM_V;
      pv_split(o, vb, pa0, pa1, p0, p1, mn_, l_reg, alpha);
    }
    asm volatile("s_waitcnt vmcnt(0)" ::: "memory");
    __syncthreads();
  }
  if (hi == 0) li_l[r32] = l_reg; asm volatile("s_waitcnt lgkmcnt(0)" ::: "memory");
  if (act) {
    float rli[16];
#pragma unroll
    for (int r = 0; r < 16; ++r) rli[r] = __builtin_amdgcn_rcpf(li_l[crow(r, hi)]);
    bf16_t* st = (bf16_t*)(lds + wid * 8192);
    bf16_t* Ow = Ob + (long)(wid * QBLK) * LD;
#pragma unroll
    for (int hv = 0; hv < 2; ++hv) {
#pragma unroll
      for (int r = 0; r < 16; ++r) { const int orow = crow(r, hi);
#pragma unroll
        for (int d0 = 0; d0 < 4; ++d0) { const float v = o[hv * 4 + d0][r] * rli[r]; unsigned u = __float_as_uint(v); u = (u + 0x7fffu + ((u >> 16) & 1u)) >> 16; st[orow * 128 + d0 * 32 + r32] = (bf16_t)u; } }
      asm volatile("s_waitcnt lgkmcnt(0)" ::: "memory");
#pragma unroll
      for (int i = 0; i < 4; ++i) { const int row = i * 8 + (lane >> 3), ch = lane & 7; const u32x4 v = *(const u32x4*)(st + row * 128 + ch * 8), v2 = *(const u32x4*)(st + row * 128 + 64 + ch * 8);
        *(u32x4*)(Ow + (long)row * LD + hv * 128 + ch * 8) = v; *(u32x4*)(Ow + (long)row * LD + hv * 128 + 64 + ch * 8) = v2; }
      asm volatile("s_waitcnt lgkmcnt(0)" ::: "memory");
    }
  }
  __syncthreads();
#undef KDMA
#undef VDMA
}
#undef KSWZ
#undef SBAR
#undef LAS_
}
#define XB_TMO      128
#define XB_XCNT(j)  (256  + 64 * (j))
#define XB_XSUB(j)  (1280 + 64 * (j))
#define XB_XGEN(j)  (2304 + 64 * (j))
#define XB_TOP      3328
#define XB_TOPGEN   3392
#define XCD_BAR_WORDS 3456
#define XB_SPIN_CAP (1u << 22)

__device__ __forceinline__ unsigned xb_ld(unsigned* p)              { return __hip_atomic_load(p, __ATOMIC_RELAXED, __HIP_MEMORY_SCOPE_AGENT); }
__device__ __forceinline__ unsigned xb_add(unsigned* p, unsigned v) { return __hip_atomic_fetch_add(p, v, __ATOMIC_RELAXED, __HIP_MEMORY_SCOPE_AGENT); }
__device__ __forceinline__ unsigned xb_xcc_id() { return (unsigned)__builtin_amdgcn_s_getreg((3 << 11) | 20) & 0xFu; }
#define XB_SPIN(cond, bar) do { unsigned _sp = 0; while (cond) { __builtin_amdgcn_s_sleep(1); \
    if ((++_sp & 255u) == 0u) { if (xb_ld(&(bar)[XB_TMO])) break; if (_sp > XB_SPIN_CAP) { atomicAdd(&(bar)[XB_TMO], 1u); break; } } } } while (0)

struct XcdBarrier {
    unsigned* bar; unsigned x;
    volatile LAS unsigned* st;
};

__device__ __forceinline__ XcdBarrier xcd_barrier_post(unsigned* bar, volatile LAS unsigned* st) {
    XcdBarrier b; b.bar = bar; b.x = xb_xcc_id(); b.st = st;
    if (threadIdx.x == 0) (void)xb_add(&bar[XB_XCNT(b.x)], 1u);
    return b;
}
__device__ __forceinline__ void xcd_barrier_complete(unsigned* bar, unsigned x, unsigned& nloc, unsigned& nx) {
    const unsigned G = gridDim.x * gridDim.y * gridDim.z;
    unsigned sum, cnt, mine, sp = 0u;
    for (;;) {
        sum = 0u; cnt = 0u; mine = 0u;
#pragma unroll
        for (unsigned j = 0; j < 16; ++j) { const unsigned c = xb_ld(&bar[XB_XCNT(j)]); sum += c; cnt += (c > 0u) ? 1u : 0u; mine = (j == x) ? c : mine; }
        if (sum == G) break;
        __builtin_amdgcn_s_sleep(1);
        if ((++sp & 255u) == 0u) { if (xb_ld(&bar[XB_TMO])) break; if (sp > XB_SPIN_CAP) { atomicAdd(&bar[XB_TMO], 1u); break; } }
    }
    nloc = mine > 0u ? mine : 1u; nx = cnt > 0u ? cnt : 1u;
}

__device__ __forceinline__ void xcd_barrier(const XcdBarrier& b) {
    asm volatile("s_waitcnt vmcnt(0)" ::: "memory");
    __syncthreads();
    if (threadIdx.x == 0) {
        unsigned* bar = b.bar;
        __builtin_amdgcn_s_waitcnt(0);
        unsigned nloc = b.st[0], nx = b.st[1];
        if (nloc == 0u) { xcd_barrier_complete(bar, b.x, nloc, nx); b.st[0] = nloc; b.st[1] = nx; }
        const unsigned old = xb_add(&bar[XB_XSUB(b.x)], 1u);
        const unsigned gen = old / nloc;
        if (old + 1u == (gen + 1u) * nloc) {
            __builtin_amdgcn_fence(__ATOMIC_RELEASE, "agent");
            asm volatile("s_waitcnt vmcnt(0)" ::: "memory");
            const unsigned og = xb_add(&bar[XB_TOP], 1u);
            const unsigned tg = og / nx;
            if (og + 1u == (tg + 1u) * nx) xb_add(&bar[XB_TOPGEN], 1u);
            else XB_SPIN(xb_ld(&bar[XB_TOPGEN]) == tg, bar);
            __builtin_amdgcn_fence(__ATOMIC_ACQUIRE, "agent");
            xb_add(&bar[XB_XGEN(b.x)], 1u);
            asm volatile("s_waitcnt vmcnt(0)" ::: "memory");
        } else {
            XB_SPIN(xb_ld(&bar[XB_XGEN(b.x)]) == gen, bar);
            __builtin_amdgcn_fence(__ATOMIC_ACQUIRE, "agent");
            asm volatile("s_waitcnt vmcnt(0)" ::: "memory");
        }
    }
    __syncthreads();
}
__device__ __forceinline__ void norm_row(const float* xrow, const float* gain, int lane, f32x4 (&v)[8]) {
    const GAS f32x4* xr = (const GAS f32x4*)xrow + lane; float s = 0.f;
#pragma unroll
    for (int j = 0; j < 8; ++j) { v[j] = xr[64 * j]; s += (v[j].x * v[j].x + v[j].y * v[j].y) + (v[j].z * v[j].z + v[j].w * v[j].w); }
    const float rstd = 1.f / sqrtf(wave_sum(s) * (1.f / DM) + EPS);
    const GAS f32x4* gr = (const GAS f32x4*)gain + lane;
#pragma unroll
    for (int j = 0; j < 8; ++j) { const f32x4 g = gr[64 * j]; v[j] = v[j] * rstd * g; }
}
__device__ __forceinline__ void store_row_bf16(bf16* orow, int lane, const f32x4 (&v)[8]) {
    GAS v2u* o8 = (GAS v2u*)orow + lane;
#pragma unroll
    for (int j = 0; j < 8; ++j) { v2u w; w.x = pk2(v[j].x, v[j].y); w.y = pk2(v[j].z, v[j].w); o8[64 * j] = w; }
}
__device__ __forceinline__ void transpose_item(const float* W, int N, bf16* WT, int ldo, int koff, int orow0, int k0, int n0, LAS float* scr, int lane, const float* gk) {
#pragma unroll 8
    for (int i = 0; i < 32; ++i) { const int kk = 2 * i + (lane >> 5); scr[kk * 33 + (lane & 31)] = __builtin_nontemporal_load(&W[(size_t)(k0 + kk) * N + n0 + (lane & 31)]); }
    LDS_WAIT(); asm volatile("" ::: "memory");
    const int c = lane & 7;
    f32x4 g0 = {1.f, 1.f, 1.f, 1.f}, g1 = g0; if (gk) { g0 = *(const GAS f32x4*)(gk + k0 + 8 * c); g1 = *(const GAS f32x4*)(gk + k0 + 8 * c + 4); }
#pragma unroll
    for (int j = 0; j < 4; ++j) { const int n = (lane >> 3) + 8 * j; const LAS float* s = scr + (8 * c) * 33 + n;
        v4u o; o.x = pk2(s[0 * 33] * g0.x, s[1 * 33] * g0.y); o.y = pk2(s[2 * 33] * g0.z, s[3 * 33] * g0.w); o.z = pk2(s[4 * 33] * g1.x, s[5 * 33] * g1.y); o.w = pk2(s[6 * 33] * g1.z, s[7 * 33] * g1.w);
        __builtin_nontemporal_store(o, (GAS v4u*)(WT + (size_t)(orow0 + n) * ldo + koff + k0 + 8 * c)); }
    LDS_WAIT(); asm volatile("" ::: "memory");
}
__device__ __forceinline__ int rel_bucket(int rel) {
    const int n = rel < 0 ? -rel : rel; int b;
    if (n < 8) b = n; else if (n < 12) b = 8; else if (n < 16) b = 9; else if (n < 23) b = 10; else if (n < 32) b = 11; else if (n < 46) b = 12; else if (n < 64) b = 13; else if (n < 91) b = 14; else b = 15;
    return b + (rel > 0 ? 16 : 0);
}

#ifndef SKIP_P0
#define SKIP_P0 0
#endif
#ifndef SKIP_N1
#define SKIP_N1 0
#endif
#ifndef SKIP_GIN
#define SKIP_GIN 0
#endif
#ifndef SKIP_ATT
#define SKIP_ATT 0
#endif
#ifndef SKIP_COMB
#define SKIP_COMB 0
#endif
#ifndef SKIP_GBR
#define SKIP_GBR 0
#endif
#ifndef SKIP_GOUT
#define SKIP_GOUT 0
#endif
#ifndef SKIP_N2
#define SKIP_N2 0
#endif
#ifndef SKIP_GUP
#define SKIP_GUP 0
#endif
#ifndef SKIP_GDN
#define SKIP_GDN 0
#endif
#ifndef SKIP_N3
#define SKIP_N3 0
#endif
#ifndef SKIP_GPLE
#define SKIP_GPLE 0
#endif
constexpr int KV_CHL = 8 * 1024 * 2048 / 8;
#ifndef KV_F1_NUM
#define KV_F1_NUM 6
#define KV_F2_NUM 20
#endif
constexpr int KV_F1 = KV_F1_NUM * (KV_CHL / 16), KV_F2 = KV_F2_NUM * (KV_CHL / 16);
template <int UNR> __device__ __forceinline__ void kv_convert1(const float* src, size_t wsoff, unsigned char* ws, int L, int jb, int je, int wk, int nwk, int lane) {
    const GAS f32x4* s4 = (const GAS f32x4*)(src + (size_t)L * KV_CHL * 8); bf16* dst = (bf16*)(ws + wsoff) + (size_t)L * DB * KROWS * DM;
    for (int j0 = jb + wk * (64 * UNR); j0 < je; j0 += nwk * (64 * UNR)) {
        f32x4 a[UNR], b[UNR];
#pragma unroll
        for (int u = 0; u < UNR; ++u) { const int j = j0 + u * 64 + lane; a[u] = __builtin_nontemporal_load(s4 + 2 * (size_t)j); b[u] = __builtin_nontemporal_load(s4 + 2 * (size_t)j + 1); }
#pragma unroll
        for (int u = 0; u < UNR; ++u) { const int j = j0 + u * 64 + lane; const int row = j >> 8, col = (j & 255) * 8;
            v4u o; o.x = pk2(a[u].x, a[u].y); o.y = pk2(a[u].z, a[u].w); o.z = pk2(b[u].x, b[u].y); o.w = pk2(b[u].z, b[u].w);
            __builtin_nontemporal_store(o, (GAS v4u*)(dst + ((size_t)(row >> 10) * KROWS + (row & 1023)) * DM + col)); }
    }
}
__device__ __forceinline__ void kv_convert1_dma(const float* src, size_t wsoff, unsigned char* ws, int L, int jb, int je, int wk, int nwk, int lane, LAS unsigned char* myl) {
    const float* s0 = src + (size_t)L * KV_CHL * 8; bf16* dst = (bf16*)(ws + wsoff) + (size_t)L * DB * KROWS * DM;
    for (int j0 = jb + wk * 512; j0 < je; j0 += nwk * 512) {
        const float* g = s0 + (size_t)j0 * 8 + lane * 4;
#pragma unroll
        for (int i = 0; i < 16; ++i) __builtin_amdgcn_global_load_lds((const unsigned*)(g + i * 256), (LAS unsigned*)(myl + i * 1024), 16, 0, 0);
        asm volatile("s_waitcnt vmcnt(0)" ::: "memory");
#pragma unroll
        for (int u = 0; u < 8; ++u) { const int c = u * 64 + lane, j = j0 + c; const int row = j >> 8, col = (j & 255) * 8;
            const f32x4 a = *(const LAS f32x4*)(myl + c * 32), b = *(const LAS f32x4*)(myl + c * 32 + 16);
            v4u o; o.x = pk2(a.x, a.y); o.y = pk2(a.z, a.w); o.z = pk2(b.x, b.y); o.w = pk2(b.z, b.w);
            __builtin_nontemporal_store(o, (GAS v4u*)(dst + ((size_t)(row >> 10) * KROWS + (row & 1023)) * DM + col)); }
        asm volatile("s_waitcnt lgkmcnt(0)" ::: "memory");
    }
}
template <int JB, int JE> __device__ __forceinline__ void kv_convert_dma(const float* kin, const float* vin, unsigned char* ws, int L, int wk, int nwk, int lane, LAS unsigned char* myl) {
    constexpr int kb = JB < KV_CHL ? JB : KV_CHL, ke = JE < KV_CHL ? JE : KV_CHL, vb = (JB > KV_CHL ? JB : KV_CHL) - KV_CHL, ve = (JE > KV_CHL ? JE : KV_CHL) - KV_CHL;
    if constexpr (kb < ke) kv_convert1_dma(kin, WS_KALL, ws, L, kb, ke, wk, nwk, lane, myl);
    if constexpr (vb < ve) kv_convert1_dma(vin, WS_VALL, ws, L, vb, ve, wk, nwk, lane, myl);
}
template <int JB, int JE, int UNR> __device__ __forceinline__ void kv_convert(const float* kin, const float* vin, unsigned char* ws, int L, int wk, int nwk, int lane) {
    constexpr int kb = JB < KV_CHL ? JB : KV_CHL, ke = JE < KV_CHL ? JE : KV_CHL, vb = (JB > KV_CHL ? JB : KV_CHL) - KV_CHL, ve = (JE > KV_CHL ? JE : KV_CHL) - KV_CHL;
    if constexpr (kb < ke) kv_convert1<UNR>(kin, WS_KALL, ws, L, kb, ke, wk, nwk, lane);
    if constexpr (vb < ve) kv_convert1<UNR>(vin, WS_VALL, ws, L, vb, ve, wk, nwk, lane);
}
struct Args { const float* in[27]; float* out; unsigned char* ws; int ph_lo, ph_hi; };
#define CAS __attribute__((address_space(4)))
constexpr int NPH_LAYER = 8, PH_FINAL = 1 + DEPTH * NPH_LAYER, NPHASES = PH_FINAL + 1;
constexpr int TR_ITEMS_LAYER = 37632;

#define X ((bf16*)(ws + WS_X))
#define AH ((bf16*)(ws + WS_AH))
#define APLE ((bf16*)(ws + WS_APLE + (size_t)L * APLE_BYTES))
#define SS(i) ((bf16*)(ws + WS_SSP) + (size_t)(i) * M * 8)
#define LQ ((LAS float*)(ldsl + LDS_SSQ))
#define ZC ((bf16*)(ws + WS_ZC))
#define QB ((bf16*)(ws + WS_QB))
#define KB ((bf16*)(ws + WS_KB))
#define VB ((bf16*)(ws + WS_VB))
#define GG ((bf16*)(ws + WS_GG))
#define OP ((bf16*)(ws + WS_OP))
#define ABR ((bf16*)(ws + WS_ABR))
#define MB ((bf16*)(ws + WS_MB))
#define ACT ((bf16*)(ws + WS_ACT))
#define PP ((bf16*)(ws + WS_PP))
#define WL ((bf16*)(ws + WS_W + (size_t)L * LW_BYTES))
#define KALL ((bf16*)(ws + WS_KALL) + (size_t)L * DB * KROWS * DM)
#define VALL ((bf16*)(ws + WS_VALL) + (size_t)L * DB * KROWS * DM)
__global__ void __launch_bounds__(NWAVES * 64, 2) trunk_fwd(Args args) {
    extern __shared__ __attribute__((aligned(16))) unsigned char lds[];
    LAS unsigned char* ldsl = (LAS unsigned char*)lds;
    volatile LAS unsigned* MISC = (volatile LAS unsigned*)(ldsl + MISC_OFF);
    const int tid0 = threadIdx.x, wave = __builtin_amdgcn_readfirstlane(tid0 >> 6);
#define PHASE_TID() int tid = threadIdx.x; asm volatile("" : "+v"(tid)); const int lane = tid & 63; (void)lane;     \
    const CAS Args* ka = (const CAS Args*)__builtin_amdgcn_kernarg_segment_ptr(); asm volatile("" : "+s"(ka)); unsigned char* ws = ka->ws; float* out = ka->out; (void)out; (void)ws; int gw = gw0; asm volatile("" : "+s"(gw)); (void)gw; int Gq = G, bxq = bx, vcuq = vcu; asm volatile("" : "+s"(Gq), "+s"(bxq), "+s"(vcuq)); (void)Gq; (void)bxq; (void)vcuq
#define KV_TAIL(NUNITS, JB, JE, LAYER) do { int t2_ = threadIdx.x; asm volatile("" : "+v"(t2_)); const int lane2_ = t2_ & 63, wave2_ = __builtin_amdgcn_readfirstlane(t2_ >> 6); \
        const CAS Args* kb_ = (const CAS Args*)__builtin_amdgcn_kernarg_segment_ptr(); asm volatile("" : "+s"(kb_)); int G2_ = gridDim.x, b2_ = blockIdx.x; asm volatile("" : "+s"(G2_), "+s"(b2_)); \
        const int rem_ = (NUNITS) % G2_; \
        LAS unsigned char* myl_ = ldsl + RING_OFF + wave2_ * 16384; \
        if (rem_ == 0) kv_convert_dma<(JB), (JE)>(kb_->in[4], kb_->in[5], kb_->ws, (LAYER), b2_ * NWAVES + wave2_, G2_ * NWAVES, lane2_, myl_); \
        else if (b2_ >= rem_) kv_convert_dma<(JB), (JE)>(kb_->in[4], kb_->in[5], kb_->ws, (LAYER), (b2_ - rem_) * NWAVES + wave2_, (G2_ - rem_) * NWAVES, lane2_, myl_); } while (0)
    const int G = gridDim.x; const int bx = blockIdx.x; const int vcu = (G % 8 == 0) ? (bx % 8) * (G / 8) + bx / 8 : bx;
    unsigned* ctl = (unsigned*)(args.ws + WS_CTL);
    for (int u = tid0; u < (LDS_BYTES - LDSCTL_OFF) / 4; u += NWAVES * 64) ((LAS unsigned*)(ldsl + LDSCTL_OFF))[u] = 0u;
    __syncthreads();
    XcdBarrier bar = xcd_barrier_post(ctl + CW_BAR, MISC + 8);
    const int lo = args.ph_lo, hi = args.ph_hi;
#define IN(k) (lo <= (k) && (k) < hi)
#define SEAM(k) do { if (IN((k) + 1)) xcd_barrier(bar); } while (0)
    const int gw0 = vcu * NWAVES + wave, NGW = G * NWAVES;

    if (IN(0) && !SKIP_P0) {
            PHASE_TID();
        LAS float* scr = (LAS float*)(ldsl + RING_OFF + wave * 16384);
        for (int it = gw; it < DEPTH * TR_ITEMS_LAYER; it += NGW) {
            const int L = it / TR_ITEMS_LAYER; int r = it % TR_ITEMS_LAYER;
            const float* W; int K, N, ldo, koff, map = 0; bf16* dst; const float* gk = nullptr;
            if (r < 13312) { W = ka->in[9]; K = DM; N = DIN; dst = WL + LW_IN / 2; ldo = DM; koff = 0; gk = ka->in[8] + (size_t)L * DM; }
            else if ((r -= 13312) < 1024) { W = ka->in[16]; K = DCONV; N = DM; dst = WL + LW_BR / 2; ldo = KBR; koff = 0; }
            else if ((r -= 1024) < 2048) { W = ka->in[17]; K = DATTN; N = DM; dst = WL + LW_BR / 2; ldo = KBR; koff = DCONV; }
            else if ((r -= 2048) < 2048) { W = ka->in[18]; K = DM; N = DM; dst = WL + LW_OUT / 2; ldo = DM; koff = 0; }
            else if ((r -= 2048) < 5632) { W = ka->in[20]; K = DM; N = DFF; dst = WL + LW_13 / 2; ldo = DM; koff = 0; map = 1; gk = ka->in[19] + (size_t)L * DM; }
            else if ((r -= 5632) < 5632) { W = ka->in[21]; K = DM; N = DFF; dst = WL + LW_13 / 2; ldo = DM; koff = 0; map = 2; gk = ka->in[19] + (size_t)L * DM; }
            else if ((r -= 5632) < 5632) { W = ka->in[22]; K = DFF; N = DM; dst = WL + LW_2 / 2; ldo = DFF; koff = 0; }
            else if ((r -= 5632) < 256) { W = ka->in[24]; K = DPLE; N = DM; dst = WL + LW_PLE / 2; ldo = KPLE; koff = 0; }
            else { r -= 256; W = ka->in[25]; K = DM; N = DM; dst = WL + LW_PLE / 2; ldo = KPLE; koff = DPLE; }
            W += (size_t)L * K * N;
            const int nblk = N / 32, kb = r / nblk, nb = r % nblk, n0 = 32 * nb;
            const int orow0 = map == 0 ? n0 : ((n0 >> 7) * 256 + (n0 & 127) + (map == 2 ? 128 : 0));
            transpose_item(W, N, dst, ldo, koff, orow0, 64 * kb, n0, scr, lane, gk);
        }
        kv_convert<KV_F1, 2 * KV_CHL, 4>(ka->in[4], ka->in[5], ws, 0, gw, NGW, lane);
        for (int Lk = 1; Lk < DEPTH; ++Lk) kv_convert<KV_F2, 2 * KV_CHL, 4>(ka->in[4], ka->in[5], ws, Lk, gw, NGW, lane);
        {
            for (int m = gw; m < M; m += NGW) {
                const float* xrow = m < MP ? ka->in[0] + (size_t)m * DM : ka->in[1] + (size_t)(m - MP) * DM;
                const GAS f32x4* xr = (const GAS f32x4*)xrow + lane; GAS v2u* xo = (GAS v2u*)(X + (size_t)m * DM) + lane; f32x4 v[8]; float s = 0.f;
#pragma unroll
                for (int j = 0; j < 8; ++j) { v[j] = xr[64 * j]; v2u w_; w_.x = pk2(v[j].x, v[j].y); w_.y = pk2(v[j].z, v[j].w); xo[64 * j] = w_; s += (v[j].x * v[j].x + v[j].y * v[j].y) + (v[j].z * v[j].z + v[j].w * v[j].w); }
                s = wave_sum(s); if (lane < 8) SS(0)[(size_t)m * 8 + lane] = lane == 0 ? (bf16)f2bf(s) : (bf16)0;
            }
        }
        {
            constexpr int CHL = M * DPLE / 8;
            for (int c = vcu * (NWAVES * 64) + tid; c < DEPTH * CHL; c += G * NWAVES * 64) {
                const int L = c / CHL, cc = c % CHL, row = cc >> 5, col = (cc & 31) * 8;
                const float* src = row < MP ? ka->in[2] + ((size_t)L * MP + row) * DPLE + col : ka->in[3] + ((size_t)L * MS + (row - MP)) * DPLE + col;
                const f32x4 a = ((const GAS f32x4*)src)[0], b = ((const GAS f32x4*)src)[1]; v4u o; o.x = pk2(a.x, a.y); o.y = pk2(a.z, a.w); o.z = pk2(b.x, b.y); o.w = pk2(b.z, b.w);
                *(GAS v4u*)(APLE + (size_t)row * KPLE + col) = o;
            }
        }
        SEAM(0);
    }

    for (int L = 0; L < DEPTH; ++L) {
        const int pb = 1 + L * NPH_LAYER;
        const float lam_init = 0.8f - 0.6f * expf(-0.3f * (float)L);

        if (IN(pb + 0) && !SKIP_GIN) {
            PHASE_TID();
            pg8::Gemm g{X, WL + LW_IN / 2, M, DIN, DM};     pg8::StaticOrder S; S.init(M, DIN, Gq, bxq);
            pg8::EpiIn E{ws, out, L, SS(3 * L + 0)};
            pg8::gemm_phase<pg8::EpiIn, pg8::StaticOrder, true, true>(ldsl + RING_OFF, g, S, E);
            { KV_TAIL((M / 256) * (DIN / 256), 0, KV_F1, L); }
            SEAM(pb + 0);
        }
        if (IN(pb + 1) && !SKIP_ATT) {
            PHASE_TID();
            float* tab = (float*)(lds + att2::OFF_TAB);
            for (int it = vcuq; it < 256; it += Gq) {
                const int bh = it >> 3, k = it & 7, b = bh >> 3, h = bh & 7, j = k & 1, role = k >> 1;
                if (tid < att2::NTAB) { const int rel = tid - 91; tab[tid] = (tid < 155) ? ka->in[7][rel_bucket(rel) * NH + h] * att::LOG2E : 0.f; }
                const int nitem = role < 2 ? 2 : 3;
                for (int qi = 0; qi < nitem; ++qi) {
                    const int code = role == 0 ? (qi == 0 ? 7 : 8) : role == 1 ? (qi == 0 ? 6 : 3) : role == 2 ? (qi == 0 ? 5 : qi == 1 ? 2 : 0) : (qi == 0 ? 4 : qi == 1 ? 1 : 9);
                    const bool prompt = code < 8; const int qb = code, sb = 2 * b + (code - 8);
                    const size_t rq = prompt ? (size_t)b * SEQ + 256 * qb : (size_t)MP + sb * DSEQ, rk = prompt ? (size_t)b * SEQ : (size_t)sb * KROWS;
                    const bf16* Kp = prompt ? KB : KALL; const bf16* Vp = prompt ? VB : VALL;
                    att2::attn_unit(QB + rq * DM + h * 256 + j * 128, Kp + rk * DM + h * 256 + j * 128, Vp + rk * DM + h * 256,
                                    OP + (size_t)j * M * DM + rq * DM + h * 256, prompt ? 4 * (qb + 1) : 18, prompt ? 4 * qb + (wave >> 1) + 1 : 17,
                                    prompt ? 256 * qb : PAST, prompt ? 256 : DSEQ, (char*)lds);
                }
            }
            SEAM(pb + 1);
        }
        if (IN(pb + 2) && !SKIP_COMB) {
            PHASE_TID();
            float lam;
            {   const float* q1 = ka->in[11] + L * HD; const float* k1 = ka->in[12] + L * HD; const float* q2 = ka->in[13] + L * HD; const float* k2 = ka->in[14] + L * HD;
                const float s1 = wave_sum(q1[lane] * k1[lane] + q1[lane + 64] * k1[lane + 64]), s2 = wave_sum(q2[lane] * k2[lane] + q2[lane + 64] * k2[lane + 64]);
                lam = expf(s1) - expf(s2) + lam_init; }
            const GAS f32x4* gsp = (const GAS f32x4*)(ka->in[15] + (size_t)L * 256 + (lane & 31) * 8); const f32x4 gs0 = gsp[0], gs1 = gsp[1];
            const float osc = 1.f - lam_init;
            for (int m = gw; m < M; m += NGW) {
                const bf16* o1 = OP + (size_t)m * DM; const bf16* o2 = OP + (size_t)M * DM + (size_t)m * DM; bf16* orow = ABR + (size_t)m * KBR + DCONV;
                v4u aw[4], cw2[4];
#pragma unroll
                for (int i = 0; i < 4; ++i) { aw[i] = ((const GAS v4u*)(o1 + i * 512))[lane]; cw2[i] = ((const GAS v4u*)(o2 + i * 512))[lane]; }
#pragma unroll
                for (int i = 0; i < 4; ++i) {
                    const f32x4 d0 = (f32x4){bf_lo(aw[i].x), bf_hi(aw[i].x), bf_lo(aw[i].y), bf_hi(aw[i].y)} - lam * (f32x4){bf_lo(cw2[i].x), bf_hi(cw2[i].x), bf_lo(cw2[i].y), bf_hi(cw2[i].y)};
                    const f32x4 d1 = (f32x4){bf_lo(aw[i].z), bf_hi(aw[i].z), bf_lo(aw[i].w), bf_hi(aw[i].w)} - lam * (f32x4){bf_lo(cw2[i].z), bf_hi(cw2[i].z), bf_lo(cw2[i].w), bf_hi(cw2[i].w)};
                    const float ss = half_sum(((d0.x * d0.x + d0.y * d0.y) + (d0.z * d0.z + d0.w * d0.w)) + ((d1.x * d1.x + d1.y * d1.y) + (d1.z * d1.z + d1.w * d1.w)));
                    const float r = osc / sqrtf(ss * (1.f / 256.f) + EPS);
                    v4u w; w.x = pk2(d0.x * r * gs0.x, d0.y * r * gs0.y); w.y = pk2(d0.z * r * gs0.z, d0.w * r * gs0.w); w.z = pk2(d1.x * r * gs1.x, d1.y * r * gs1.y); w.w = pk2(d1.z * r * gs1.z, d1.w * r * gs1.w);
                    ((GAS v4u*)(orow + i * 512))[lane] = w;
                }
            }
            const float* cw = ka->in[10] + (size_t)L * 3 * DCONV;
            for (int it = gw; it < M / 4; it += NGW) {
                const int r0 = it * 4; const bool prompt = r0 < MP;
                const int tpos = prompt ? (r0 & (SEQ - 1)) : ((r0 - MP) & (DSEQ - 1)); const int slen = prompt ? SEQ : DSEQ; const int sb = prompt ? (r0 >> 11) : ((r0 - MP) >> 6);
#pragma unroll
                for (int hf = 0; hf < 2; ++hf) {
                    const int c0 = hf * 512 + lane * 8;
                    float w0[8], w1[8], w2[8], um2[8], um1[8];
                    v4u cc[6], xx[6], bb[4];
                    const int pfirst = tpos >= 2 ? 0 : 2;
#pragma unroll
                    for (int p = 0; p < 6; ++p) { if (p >= pfirst) { const bf16* zr = ZC + (size_t)(r0 - 2 + p) * 3072; cc[p] = *(const GAS v4u*)(zr + 1024 + c0); xx[p] = *(const GAS v4u*)(zr + 2048 + c0); if (p >= 2) bb[p - 2] = *(const GAS v4u*)(zr + c0); }
                        else { cc[p] = (v4u){0u, 0u, 0u, 0u}; xx[p] = (v4u){0u, 0u, 0u, 0u}; } }
                    {   const GAS f32x4* c4 = (const GAS f32x4*)(cw + c0);
                        const f32x4 a0 = c4[0], a1 = c4[1], b0 = c4[DCONV / 4], b1 = c4[DCONV / 4 + 1], d0 = c4[2 * DCONV / 4], d1 = c4[2 * DCONV / 4 + 1];
#pragma unroll
                        for (int i = 0; i < 4; ++i) { w0[i] = a0[i]; w0[4 + i] = a1[i]; w1[i] = b0[i]; w1[4 + i] = b1[i]; w2[i] = d0[i]; w2[4 + i] = d1[i]; } }
#define CONV_U(U, C, Xx) do { U[0] = bf_lo(C.x) * bf_lo(Xx.x); U[1] = bf_hi(C.x) * bf_hi(Xx.x); U[2] = bf_lo(C.y) * bf_lo(Xx.y); U[3] = bf_hi(C.y) * bf_hi(Xx.y); \
                        U[4] = bf_lo(C.z) * bf_lo(Xx.z); U[5] = bf_hi(C.z) * bf_hi(Xx.z); U[6] = bf_lo(C.w) * bf_lo(Xx.w); U[7] = bf_hi(C.w) * bf_hi(Xx.w); } while (0)
                    if (tpos >= 2) { CONV_U(um2, cc[0], xx[0]); CONV_U(um1, cc[1], xx[1]); }
                    else if (prompt) {
#pragma unroll
                        for (int i = 0; i < 8; ++i) { um2[i] = 0.f; um1[i] = 0.f; }
                    } else {
                        const GAS f32x4* cp = (const GAS f32x4*)(ka->in[6] + ((size_t)(L * DB + sb) * 2) * DCONV + c0);
                        const f32x4 p0 = cp[0], p1 = cp[1], q0 = cp[DCONV / 4], q1 = cp[DCONV / 4 + 1];
#pragma unroll
                        for (int i = 0; i < 4; ++i) { um2[i] = p0[i]; um2[4 + i] = p1[i]; um1[i] = q0[i]; um1[4 + i] = q1[i]; }
                    }
#pragma unroll
                    for (int p = 0; p < 4; ++p) {
                        float u[8], bv[8], a[8];
                        CONV_U(u, cc[2 + p], xx[2 + p]);
                        const v4u b4 = bb[p];
                        bv[0] = bf_lo(b4.x); bv[1] = bf_hi(b4.x); bv[2] = bf_lo(b4.y); bv[3] = bf_hi(b4.y); bv[4] = bf_lo(b4.z); bv[5] = bf_hi(b4.z); bv[6] = bf_lo(b4.w); bv[7] = bf_hi(b4.w);
#pragma unroll
                        for (int i = 0; i < 8; ++i) { a[i] = bv[i] * (w0[i] * um2[i] + w1[i] * um1[i] + w2[i] * u[i]); um2[i] = um1[i]; um1[i] = u[i]; }
                        v4u o; o.x = pk2(a[0], a[1]); o.y = pk2(a[2], a[3]); o.z = pk2(a[4], a[5]); o.w = pk2(a[6], a[7]);
                        *(GAS v4u*)(ABR + (size_t)(r0 + p) * KBR + c0) = o;
                    }
#undef CONV_U
                    if (tpos + 4 == slen) {
                        float* co = prompt ? out + O_CP + ((size_t)(L * NB + sb) * 2) * DCONV + c0 : out + O_CS + ((size_t)(L * DB + sb) * 2) * DCONV + c0;
#pragma unroll
                        for (int i = 0; i < 8; ++i) { co[i] = um2[i]; co[DCONV + i] = um1[i]; }
                    }
                }
            }
            SEAM(pb + 2);
        }
        if (IN(pb + 3) && !SKIP_GBR) {
            PHASE_TID();
            pg8::Gemm g{ABR, WL + LW_BR / 2, MP, DM, KBR}; pg8::StaticOrder S; S.init(MP, DM, Gq, bxq, 2, MP);
            pg8::EpiBr E{GG, MB};
            pg8::gemm_phase<pg8::EpiBr, pg8::StaticOrder, true, true, true>(ldsl + RING_OFF, g, S, E);
            SEAM(pb + 3);
        }
        if (IN(pb + 4) && !SKIP_GOUT) {
            PHASE_TID();
            pg8::Gemm g{MB, WL + LW_OUT / 2, MP, DM, DM}; pg8::StaticOrder S; S.init(MP, DM, Gq, bxq, 1, MP);
            pg8::EpiResT<false> E{X, nullptr, nullptr, 0, 0, SS(3 * L + 1), LQ};
            pg8::gemm_phase<pg8::EpiResT<false>, pg8::StaticOrder, true, true, true>(ldsl + RING_OFF, g, S, E);
            SEAM(pb + 4);
        }
        if (IN(pb + 5) && !SKIP_GUP) {
            PHASE_TID();
            pg8::Gemm g{X, WL + LW_13 / 2, M, NUP, DM}; pg8::StaticOrder S; S.init(M, NUP, Gq, bxq);
            pg8::EpiUp E{ACT, SS(3 * L + 1)};
            pg8::gemm_phase<pg8::EpiUp, pg8::StaticOrder, true, true>(ldsl + RING_OFF, g, S, E);
            if (L + 1 < DEPTH) { KV_TAIL((M / 256) * (NUP / 256), KV_F1, KV_F2, L + 1); }
            SEAM(pb + 5);
        }
        if (IN(pb + 6) && !SKIP_GDN) {
            PHASE_TID();
            pg8::Gemm g{ACT, WL + LW_2 / 2, MP, DM, DFF}; pg8::StaticOrder S; S.init(MP, DM, Gq, bxq, 1, MP);
            pg8::EpiResT<true> E{X, ka->in[23] + (size_t)L * DM, APLE, KPLE, DPLE, SS(3 * L + 2), LQ};
            pg8::gemm_phase<pg8::EpiResT<true>, pg8::StaticOrder, true, true, true>(ldsl + RING_OFF, g, S, E);
            SEAM(pb + 6);
        }
        if (IN(pb + 7) && !SKIP_GPLE) {
            PHASE_TID();
            pg8::Gemm g{APLE, WL + LW_PLE / 2, MP, DM, KPLE}; pg8::StaticOrder S; S.init(MP, DM, Gq, bxq, 2, MP);
            pg8::EpiPle E{X, PP, SS(3 * L + 2), L + 1 < DEPTH ? ka->in[8] : nullptr, nullptr, L + 1 < DEPTH ? SS(3 * L + 3) : nullptr, LQ};
            pg8::gemm_phase<pg8::EpiPle, pg8::StaticOrder, true, true, true>(ldsl + RING_OFF, g, S, E);
            SEAM(pb + 7);
        }
    }
    if (IN(PH_FINAL)) {
        PHASE_TID();
        const float* gain = ka->in[26];
        for (int m = gw; m < M; m += NGW) {
            const GAS v2u* xr = (const GAS v2u*)(X + (size_t)m * DM) + lane; f32x4 v[8]; float sq = 0.f;
#pragma unroll
            for (int j = 0; j < 8; ++j) { const v2u w_ = xr[64 * j]; v[j] = (f32x4){bf_lo(w_.x), bf_hi(w_.x), bf_lo(w_.y), bf_hi(w_.y)}; sq += (v[j].x * v[j].x + v[j].y * v[j].y) + (v[j].z * v[j].z + v[j].w * v[j].w); }
            const float rstd = 1.f / sqrtf(wave_sum(sq) * (1.f / DM) + EPS);
            const GAS f32x4* gr = (const GAS f32x4*)gain + lane; GAS f32x4* o = (GAS f32x4*)(out + O_YP + (size_t)m * DM) + lane;
#pragma unroll
            for (int j = 0; j < 8; ++j) __builtin_nontemporal_store(v[j] * rstd * gr[64 * j], &o[64 * j]);
        }
    }
#undef IN
#undef SEAM
}

#ifndef MK_PER_PHASE
#define MK_PER_PHASE 0
#endif
extern "C" void kernel_launch(void* const* d_in, const int* in_sizes, int n_in, void* d_out, int out_size, void* d_ws, size_t ws_size, hipStream_t stream) {
    static int grid = 0;
    if (grid == 0) {
        if (n_in != 27 || in_sizes[0] != MP * DM || (size_t)out_size != O_END || ws_size < WS_END) {
            fprintf(stderr, "kernel_launch: shape mismatch: n_in %d in0 %d out %d ws %zu (need %zu); nothing launched\n", n_in, n_in > 0 ? in_sizes[0] : -1, out_size, ws_size, (size_t)WS_END); grid = -1; return; }
        int dev = 0, cus = 0, per_cu = 0;
        if (hipGetDevice(&dev) != hipSuccess || hipDeviceGetAttribute(&cus, hipDeviceAttributeMultiprocessorCount, dev) != hipSuccess) { fprintf(stderr, "kernel_launch: device query failed\n"); grid = -1; return; }
        if (hipFuncSetAttribute((const void*)trunk_fwd, hipFuncAttributeMaxDynamicSharedMemorySize, LDS_BYTES) != hipSuccess) { fprintf(stderr, "kernel_launch: hipFuncSetAttribute failed\n"); grid = -1; return; }
        if (hipOccupancyMaxActiveBlocksPerMultiprocessor(&per_cu, (const void*)trunk_fwd, NWAVES * 64, LDS_BYTES) != hipSuccess || per_cu < 1)
            fprintf(stderr, "kernel_launch: note: occupancy query reports %d workgroups per CU\n", per_cu);
        (void)hipGetLastError();
        grid = cus;
    }
    if (grid < 0) return;
    if (hipMemsetAsync((char*)d_ws + WS_CTL, 0, CTL_ZERO_BYTES, stream) != hipSuccess) { fprintf(stderr, "kernel_launch: memset failed\n"); return; }
    Args a{};
    for (int i = 0; i < 27; ++i) a.in[i] = (const float*)d_in[i];
    a.out = (float*)d_out; a.ws = (unsigned char*)d_ws;
#if MK_PER_PHASE
    for (int p = 0; p < NPHASES; ++p) { a.ph_lo = p; a.ph_hi = p + 1; hipLaunchKernelGGL(trunk_fwd, dim3(grid), dim3(NWAVES * 64), LDS_BYTES, stream, a); }
#else
    a.ph_lo = 0; a.ph_hi = NPHASES;
    hipLaunchKernelGGL(trunk_fwd, dim3(grid), dim3(NWAVES * 64), LDS_BYTES, stream, a);
#endif
    const hipError_t le = hipPeekAtLastError();
    if (le != hipSuccess) fprintf(stderr, "kernel_launch: launch failed: %s\n", hipGetErrorName(le));
}
```
